# Optimizing an MI355X kernel written in HIP

```python
import math
import jax, jax.numpy as jnp
from jax import lax
import numpy as np

D_MODEL = 1024
BATCH = 4
SEQ = 4096
DEPTH = 2

ROPE_THETA = 10000.0
Q_BLOCK = 128
EPS = 1e-6
NEG_INF = -1e30
D_FF = 2816
N_MOD = 9
DIFF_HEADS = 8
DIFF_HEAD_DIM = 64
MLA_HEADS = 8
MLA_NOPE_DIM = 64
MLA_ROPE_DIM = 32
MLA_V_DIM = 128
MLA_Q_RANK = 384
MLA_KV_RANK = 256
FOX_HEADS = 16
FOX_HEAD_DIM = 64

DIFF_QK_W = DIFF_HEADS * 2 * DIFF_HEAD_DIM
DIFF_V_W = DIFF_HEADS * 2 * DIFF_HEAD_DIM
MLA_QB_W = MLA_HEADS * (MLA_NOPE_DIM + MLA_ROPE_DIM)
MLA_KVB_W = MLA_HEADS * (MLA_NOPE_DIM + MLA_V_DIM)
EVEN_IN_W = 2 * DIFF_QK_W + DIFF_V_W + MLA_Q_RANK + MLA_KV_RANK + MLA_ROPE_DIM
EVEN_OUT_W = DIFF_V_W + MLA_HEADS * MLA_V_DIM
FOX_W = FOX_HEADS * FOX_HEAD_DIM
ODD_IN_W = 4 * FOX_W + FOX_HEADS

kernel_name = 'hybrid_diff_mla_fox_macaron_adaln'


def rms_norm(x, g=None):
    xf = x.astype(jnp.float32)
    y = xf * lax.rsqrt(jnp.mean(xf * xf, axis=-1, keepdims=True) + EPS)
    if g is not None:
        y = y * g.astype(jnp.float32)
    return y.astype(x.dtype)


def modulate(x, shift, scale):
    return rms_norm(x) * (1.0 + scale) + shift


def swiglu(h, w_gate, w_up, w_down):
    return (jax.nn.silu(h @ w_gate) * (h @ w_up)) @ w_down


def rope_tables(positions, dim):
    inv = ROPE_THETA ** (-jnp.arange(0, dim, 2, dtype=jnp.float32) / dim)
    ang = positions.astype(jnp.float32)[..., None] * inv
    return jnp.cos(ang)[:, None], jnp.sin(ang)[:, None]


def apply_rope(x, cos, sin):
    xf = x.astype(jnp.float32)
    x1, x2 = jnp.split(xf, 2, axis=-1)
    return jnp.concatenate([x1 * cos - x2 * sin, x2 * cos + x1 * sin], axis=-1).astype(x.dtype)


def to_heads(t, n):
    B, S, W = t.shape
    return t.reshape(B, S, n, W // n).transpose(0, 2, 1, 3)


def merge_heads(t):
    B, H, S, d = t.shape
    return t.transpose(0, 2, 1, 3).reshape(B, S, H * d)


def split_cols(t, widths):
    idx = [int(i) for i in np.cumsum(widths)[:-1]]
    return jnp.split(t, idx, axis=-1)


def causal_attention(q, k, v, scale, log_f_cum=None):
    B, H, S, dk = q.shape
    nb = S // Q_BLOCK
    q_blocks = q.reshape(B, H, nb, Q_BLOCK, dk).transpose(2, 0, 1, 3, 4)
    c_blocks = None if log_f_cum is None else log_f_cum.reshape(B, H, nb, Q_BLOCK).transpose(2, 0, 1, 3)
    k_pos = jnp.arange(S)

    def block(args):
        i, q_blk, c_blk = args
        q_pos = i * Q_BLOCK + jnp.arange(Q_BLOCK)
        logits = jnp.einsum('bhqd,bhkd->bhqk', q_blk, k).astype(jnp.float32) * scale
        if c_blk is not None:
            logits = logits + (c_blk[..., :, None] - log_f_cum[..., None, :])
        logits = jnp.where(k_pos[None, :] <= q_pos[:, None], logits, NEG_INF)
        p = jax.nn.softmax(logits, axis=-1)
        return jnp.einsum('bhqk,bhkd->bhqd', p.astype(v.dtype), v)

    out = lax.map(block, (jnp.arange(nb), q_blocks, c_blocks))
    return out.transpose(1, 2, 0, 3, 4).reshape(B, H, S, v.shape[-1])


def ab_mixer(h, cos_a, sin_a, cos_b, sin_b, lambda_init, w_in, w_qb, w_kvb, q_lat_g, kv_lat_g,
             diff_q_g, diff_k_g, mla_q_g, mla_k_g, lam_q1, lam_k1, lam_q2, lam_k2, subln_g, w_out):
    B, S, _ = h.shape
    q_a, k_a, v_a, c_q, c_kv, k_r = split_cols(
        h @ w_in, [DIFF_QK_W, DIFF_QK_W, DIFF_V_W, MLA_Q_RANK, MLA_KV_RANK, MLA_ROPE_DIM])

    q_a = q_a.reshape(B, S, DIFF_HEADS, 2, DIFF_HEAD_DIM)
    k_a = k_a.reshape(B, S, DIFF_HEADS, 2, DIFF_HEAD_DIM)

    def qk(t, j, g):
        return apply_rope(rms_norm(t[:, :, :, j].transpose(0, 2, 1, 3), g), cos_a, sin_a)

    q1, q2 = qk(q_a, 0, diff_q_g), qk(q_a, 1, diff_q_g)
    k1, k2 = qk(k_a, 0, diff_k_g), qk(k_a, 1, diff_k_g)
    v = to_heads(v_a, DIFF_HEADS)
    lam = (jnp.exp(jnp.sum(lam_q1.astype(jnp.float32) * lam_k1.astype(jnp.float32)))
           - jnp.exp(jnp.sum(lam_q2.astype(jnp.float32) * lam_k2.astype(jnp.float32)))
           + lambda_init)
    scale_a = DIFF_HEAD_DIM ** -0.5
    o = (causal_attention(q1, k1, v, scale_a).astype(jnp.float32)
         - lam * causal_attention(q2, k2, v, scale_a).astype(jnp.float32))
    o_a = (rms_norm(o, subln_g) * (1.0 - lambda_init)).astype(h.dtype)

    q_b = to_heads(rms_norm(c_q, q_lat_g) @ w_qb, MLA_HEADS)
    kv_b = to_heads(rms_norm(c_kv, kv_lat_g) @ w_kvb, MLA_HEADS)
    k_nope, v_b = kv_b[..., :MLA_NOPE_DIM], kv_b[..., MLA_NOPE_DIM:]
    k_rope = jnp.broadcast_to(k_r[:, None], (B, MLA_HEADS, S, MLA_ROPE_DIM))
    q_b = rms_norm(q_b, mla_q_g)
    k_b = rms_norm(jnp.concatenate([k_nope, k_rope], axis=-1), mla_k_g)
    q_b = jnp.concatenate([q_b[..., :MLA_NOPE_DIM], apply_rope(q_b[..., MLA_NOPE_DIM:], cos_b, sin_b)], axis=-1)
    k_b = jnp.concatenate([k_b[..., :MLA_NOPE_DIM], apply_rope(k_b[..., MLA_NOPE_DIM:], cos_b, sin_b)], axis=-1)
    o_b = causal_attention(q_b, k_b, v_b, (MLA_NOPE_DIM + MLA_ROPE_DIM) ** -0.5)

    return jnp.concatenate([merge_heads(o_a), merge_heads(o_b)], axis=-1) @ w_out


def fox_mixer(h, w_in, b_f, q_g, k_g, w_out):
    q, k, v, og, f_logit = split_cols(h @ w_in, [FOX_W, FOX_W, FOX_W, FOX_W, FOX_HEADS])
    q = rms_norm(to_heads(q, FOX_HEADS), q_g)
    k = rms_norm(to_heads(k, FOX_HEADS), k_g)
    v = to_heads(v, FOX_HEADS)
    log_f = jax.nn.log_sigmoid((f_logit + b_f).astype(jnp.float32))
    log_f_cum = jnp.cumsum(log_f.transpose(0, 2, 1), axis=-1)
    o = causal_attention(q, k, v, FOX_HEAD_DIM ** -0.5, log_f_cum)
    return (merge_heads(o) * jax.nn.sigmoid(og)) @ w_out


def setup_inputs(seed: int = 0) -> dict:
    key = jax.random.key(seed)
    keys = jax.random.split(key, 40)
    counter = [0]

    def nk():
        counter[0] += 1
        return keys[counter[0] - 1]

    def w(shape, fan_in, mult=1.0):
        return mult * fan_in ** -0.5 * jax.random.normal(nk(), shape, jnp.float32)

    def gain(shape):
        return 1.0 + 0.1 * jax.random.normal(nk(), shape, jnp.float32)

    n_even, n_odd = (DEPTH + 1) // 2, DEPTH // 2
    D, F = D_MODEL, D_FF
    x = jax.random.normal(nk(), (BATCH, SEQ, D), jnp.float32)
    c = jax.random.normal(nk(), (BATCH, D), jnp.float32)
    positions = (jax.random.randint(nk(), (BATCH, 1), 0, 1024, jnp.int32)
                 + jnp.arange(SEQ, dtype=jnp.int32)[None, :])
    return {
        'x': x,
        'c': c,
        'positions': positions,
        'ada_w': w((DEPTH, D, N_MOD * D), D, 0.5),
        'ada_b': 0.02 * jax.random.normal(nk(), (DEPTH, N_MOD * D), jnp.float32),
        'ff1_gate': w((DEPTH, D, F), D),
        'ff1_up': w((DEPTH, D, F), D),
        'ff1_down': w((DEPTH, F, D), F),
        'ff2_gate': w((DEPTH, D, F), D),
        'ff2_up': w((DEPTH, D, F), D),
        'ff2_down': w((DEPTH, F, D), F),
        'ab_w_in': w((n_even, D, EVEN_IN_W), D),
        'mla_w_qb': w((n_even, MLA_Q_RANK, MLA_QB_W), MLA_Q_RANK),
        'mla_w_kvb': w((n_even, MLA_KV_RANK, MLA_KVB_W), MLA_KV_RANK),
        'mla_q_lat_g': gain((n_even, MLA_Q_RANK)),
        'mla_kv_lat_g': gain((n_even, MLA_KV_RANK)),
        'diff_q_g': gain((n_even, DIFF_HEAD_DIM)),
        'diff_k_g': gain((n_even, DIFF_HEAD_DIM)),
        'mla_q_g': gain((n_even, MLA_NOPE_DIM + MLA_ROPE_DIM)),
        'mla_k_g': gain((n_even, MLA_NOPE_DIM + MLA_ROPE_DIM)),
        'diff_lam_q1': 0.1 * jax.random.normal(nk(), (n_even, DIFF_HEAD_DIM), jnp.float32),
        'diff_lam_k1': 0.1 * jax.random.normal(nk(), (n_even, DIFF_HEAD_DIM), jnp.float32),
        'diff_lam_q2': 0.1 * jax.random.normal(nk(), (n_even, DIFF_HEAD_DIM), jnp.float32),
        'diff_lam_k2': 0.1 * jax.random.normal(nk(), (n_even, DIFF_HEAD_DIM), jnp.float32),
        'diff_subln_g': gain((n_even, 2 * DIFF_HEAD_DIM)),
        'ab_w_out': w((n_even, EVEN_OUT_W, D), EVEN_OUT_W),
        'fox_w_in': w((n_odd, D, ODD_IN_W), D),
        'fox_b_f': jax.random.uniform(nk(), (n_odd, FOX_HEADS), jnp.float32, 1.0, 5.0),
        'fox_q_g': gain((n_odd, FOX_HEAD_DIM)),
        'fox_k_g': gain((n_odd, FOX_HEAD_DIM)),
        'fox_w_out': w((n_odd, FOX_W, D), FOX_W),
    }


def reference(x, c, positions, ada_w, ada_b, ff1_gate, ff1_up, ff1_down, ff2_gate, ff2_up, ff2_down,
              ab_w_in, mla_w_qb, mla_w_kvb, mla_q_lat_g, mla_kv_lat_g, diff_q_g, diff_k_g, mla_q_g, mla_k_g,
              diff_lam_q1, diff_lam_k1, diff_lam_q2, diff_lam_k2, diff_subln_g, ab_w_out,
              fox_w_in, fox_b_f, fox_q_g, fox_k_g, fox_w_out):
    cos_a, sin_a = rope_tables(positions, DIFF_HEAD_DIM)
    cos_b, sin_b = rope_tables(positions, MLA_ROPE_DIM)
    cond = jax.nn.silu(c)
    for l in range(DEPTH):
        mod = cond @ ada_w[l] + ada_b[l]
        sh1, sc1, g1, sh2, sc2, g2, sh3, sc3, g3 = [m[:, None, :] for m in jnp.split(mod, N_MOD, axis=-1)]
        x = x + 0.5 * g1 * swiglu(modulate(x, sh1, sc1), ff1_gate[l], ff1_up[l], ff1_down[l])
        h = modulate(x, sh2, sc2)
        if l % 2 == 0:
            e = l // 2
            lambda_init = 0.8 - 0.6 * math.exp(-0.3 * l)
            mix = ab_mixer(h, cos_a, sin_a, cos_b, sin_b, lambda_init, ab_w_in[e], mla_w_qb[e], mla_w_kvb[e],
                           mla_q_lat_g[e], mla_kv_lat_g[e], diff_q_g[e], diff_k_g[e], mla_q_g[e], mla_k_g[e],
                           diff_lam_q1[e], diff_lam_k1[e], diff_lam_q2[e], diff_lam_k2[e], diff_subln_g[e],
                           ab_w_out[e])
        else:
            o = l // 2
            mix = fox_mixer(h, fox_w_in[o], fox_b_f[o], fox_q_g[o], fox_k_g[o], fox_w_out[o])
        x = x + g2 * mix
        x = x + 0.5 * g3 * swiglu(modulate(x, sh3, sc3), ff2_gate[l], ff2_up[l], ff2_down[l])
    return x
```

```cpp
#include <hip/hip_runtime.h>
#include <hip/hip_cooperative_groups.h>
#include <cstdio>
#include <cstdint>
namespace cg = cooperative_groups;
namespace pg8 {
#define PG8_LAS __attribute__((address_space(3)))
typedef unsigned short bf16_t;
typedef short bf16x8 __attribute__((ext_vector_type(8)));
typedef float f32x4 __attribute__((ext_vector_type(4)));
typedef unsigned u32x4 __attribute__((ext_vector_type(4)));
constexpr int BM = 256, BK = 64, HALF = 128, HTB = HALF * BK * 2  , STAGE_BYTES = 8 * HTB, NXCD = 8, WGM = 8;

__host__ __device__ __forceinline__ int lds_byte(int r, int c) { const int st = (r >> 4) * 2 + (c >> 5), rr = r & 15, cc = c & 31, ob = rr * 64 + cc * 2; return st * 1024 + (ob ^ (((ob >> 9) & 1) << 5)); }
__host__ __device__ __forceinline__ void stage_rc(int b, int& R, int& C) { const int st = b / 1024, sb = b % 1024, swz = sb ^ (((sb >> 9) & 1) << 5); R = (st >> 1) * 16 + swz / 64; C = (st & 1) * 32 + (swz % 64) / 2; }
__host__ __device__ __forceinline__ int perm32(int rho) { const int n = rho >> 4, i = rho & 15; return 8 * (i >> 2) + 4 * n + (i & 3); }

struct Unit { int pm, pn; };
struct Gemm { const bf16_t* A; const bf16_t* Bt; int M, N, K; };

struct StaticOrder {
    int nM, nN, nwg, G, c;
    __host__ __device__ void init(int M, int N, int G_, int c_) { nM = M / BM; nN = N / BM; nwg = nM * nN; G = G_; c = c_; }
    __host__ __device__ bool next(int i, Unit& u) const {
        const long L = (long)i * G + c; if (L >= nwg) return false;
        int wgid = (int)L; { const int q = nwg / NXCD, r = nwg % NXCD, xcd = wgid % NXCD, off = wgid / NXCD; wgid = (xcd < r ? xcd * (q + 1) : r * (q + 1) + (xcd - r) * q) + off; }
        const int nig = WGM * nN, gid = wgid / nig, fm = gid * WGM, gsz = (nM - fm) < WGM ? (nM - fm) : WGM;
        u.pm = fm + ((wgid % nig) % gsz); u.pn = (wgid % nig) / gsz; return true;
    }
    __device__ __forceinline__ void a_ready(const Unit&) const {}
    __device__ __forceinline__ void done(const Unit&) const {}
};

__device__ __forceinline__ unsigned cvt_pk_bf16(float lo, float hi) { unsigned r; asm volatile("v_cvt_pk_bf16_f32 %0, %1, %2" : "=v"(r) : "v"(lo), "v"(hi)); return r; }
typedef float f32x2 __attribute__((ext_vector_type(2)));
template <class Epi, class Sched, bool ALIGN_EPI = false, bool SP2 = false>
__device__ __forceinline__ void gemm_phase(PG8_LAS unsigned char* lds, const Gemm g, const Sched& S, const Epi& E, const int tid_in) {
    const int tid = tid_in, wid = __builtin_amdgcn_readfirstlane(tid >> 6), lane = tid & 63, wr = wid >> 2, wc = wid & 3, fr = lane & 15, fq = lane >> 4;
    const int K = g.K, nt = K / BK;
    unsigned voffA[2], voffB[2];
#pragma unroll
    for (int i = 0; i < 2; ++i) { int R, C; stage_rc(tid * 16 + i * 8192, R, C); const int Rb = Epi::PERM ? ((R & ~31) + perm32(R & 31)) : R;
        voffA[i] = (unsigned)(R * K + C) * 2u; voffB[i] = (unsigned)(Rb * K + C) * 2u; }
    const size_t kstep = (size_t)(BK * 2);
    const size_t hstep = (size_t)HALF * K * 2;
    const size_t tstep = 2 * hstep;
    const unsigned ldsw = (unsigned)wid * 1024u;
    const int aoff = lds_byte(wr * 64 + fr, fq * 8), boff = lds_byte(wc * 32 + fr, fq * 8);
#define PG8_SA(b, h) (((b) * 2 + (h)) * HTB)
#define PG8_SB(b, h) ((4 + (b) * 2 + (h)) * HTB)
#define PG8_STAGE(bufoff, gbase, voff) do { _Pragma("unroll") for (int _i = 0; _i < 2; ++_i) \
        __builtin_amdgcn_global_load_lds((const unsigned*)((const char*)(gbase) + (voff)[_i]), (PG8_LAS unsigned*)(lds + (bufoff) + ldsw + _i * 8192), 16, 0, 0); } while (0)
#define PG8_LDA(dst, b, h) do { _Pragma("unroll") for (int m = 0; m < 4; ++m) _Pragma("unroll") for (int k = 0; k < 2; ++k) dst[m][k] = *(const PG8_LAS bf16x8*)(lds + PG8_SA(b, h) + aoff + m * 2048 + k * 1024); } while (0)
#define PG8_LDB(dst, b, h) do { _Pragma("unroll") for (int n = 0; n < 2; ++n) _Pragma("unroll") for (int k = 0; k < 2; ++k) dst[n][k] = *(const PG8_LAS bf16x8*)(lds + PG8_SB(b, h) + boff + n * 2048 + k * 1024); } while (0)
#define PG8_MMA(ai, bj, At, Bt) do { __builtin_amdgcn_s_setprio(1); _Pragma("unroll") for (int m = 0; m < 4; ++m) _Pragma("unroll") for (int n = 0; n < 2; ++n) _Pragma("unroll") for (int k = 0; k < 2; ++k) \
        acc[ai][bj][m][n] = __builtin_amdgcn_mfma_f32_16x16x32_bf16(Bt[n][k], At[m][k], acc[ai][bj][m][n], 0, 0, 0); __builtin_amdgcn_s_setprio(0); } while (0)
#define PG8_WAIT_V(n) asm volatile("s_waitcnt vmcnt(" #n ")" ::: "memory")
#define PG8_WAIT_L(n) asm volatile("s_waitcnt lgkmcnt(" #n ")" ::: "memory")
#define PG8_BAR __builtin_amdgcn_s_barrier()
#define PG8_SCHED __builtin_amdgcn_sched_barrier(0)
    Unit cur, nxt; int ui = 0;
    if (!S.next(0, cur)) return;
    f32x4 acc[2][2][4][2];
#pragma unroll
    for (int a = 0; a < 2; ++a)
#pragma unroll
        for (int b = 0; b < 2; ++b)
#pragma unroll
            for (int m = 0; m < 4; ++m)
#pragma unroll
                for (int n = 0; n < 2; ++n) acc[a][b][m][n] = (f32x4){0.f, 0.f, 0.f, 0.f};
    bf16x8 At[4][2], B0[2][2], B1[2][2];
    const char* cA = (const char*)g.A + (size_t)cur.pm * tstep; const char* cB = (const char*)g.Bt + (size_t)cur.pn * tstep;
    S.a_ready(cur);
    if constexpr (SP2) {
        PG8_STAGE(PG8_SB(0, 0), cB, voffB); PG8_STAGE(PG8_SB(0, 1), cB + hstep, voffB); PG8_STAGE(PG8_SA(0, 0), cA, voffA); PG8_STAGE(PG8_SA(0, 1), cA + hstep, voffA);
        if (wr == 1) PG8_BAR;
        PG8_WAIT_V(2); PG8_BAR;
        PG8_STAGE(PG8_SB(1, 0), cB + kstep, voffB); PG8_STAGE(PG8_SA(1, 0), cA + kstep, voffA); PG8_STAGE(PG8_SB(1, 1), cB + hstep + kstep, voffB);
        PG8_WAIT_V(6); PG8_BAR;
    } else {
        PG8_STAGE(PG8_SB(0, 0), cB, voffB); PG8_STAGE(PG8_SA(0, 0), cA, voffA); PG8_STAGE(PG8_SB(0, 1), cB + hstep, voffB); PG8_STAGE(PG8_SA(0, 1), cA + hstep, voffA);
        if (wr == 1) PG8_BAR;
        PG8_WAIT_V(4); PG8_BAR;
        PG8_STAGE(PG8_SB(1, 0), cB + kstep, voffB); PG8_STAGE(PG8_SA(1, 0), cA + kstep, voffA); PG8_STAGE(PG8_SB(1, 1), cB + hstep + kstep, voffB);
        PG8_WAIT_V(6); PG8_BAR;
    }
    for (;;) {
        const bool has_next = S.next(ui + 1, nxt);
        const char* nA = has_next ? (const char*)g.A + (size_t)nxt.pm * tstep : cA; const char* nB = has_next ? (const char*)g.Bt + (size_t)nxt.pn * tstep : cB;
        for (int t = 0; t < nt; t += 2) {
            const bool last = (t == nt - 2);
            const char* a1 = cA + (size_t)(t + 1) * kstep;
            const char* a2 = last ? nA : cA + (size_t)(t + 2) * kstep; const char* b2 = last ? nB : cB + (size_t)(t + 2) * kstep;
            const char* a3 = a2 + kstep; const char* b3 = b2 + kstep;
            if (last && has_next) S.a_ready(nxt);
            if constexpr (SP2) {
            PG8_LDB(B0, 0, 0); PG8_LDB(B1, 0, 1); PG8_SCHED; PG8_LDA(At, 0, 0); PG8_STAGE(PG8_SA(1, 1), a1 + hstep, voffA);
            PG8_WAIT_V(8); PG8_WAIT_L(0); PG8_BAR; PG8_MMA(0, 0, At, B0); PG8_MMA(0, 1, At, B1); PG8_BAR; PG8_SCHED;
            PG8_LDA(At, 0, 1); PG8_STAGE(PG8_SB(0, 0), b2, voffB); PG8_STAGE(PG8_SB(0, 1), b2 + hstep, voffB); PG8_STAGE(PG8_SA(0, 0), a2, voffA);
            PG8_WAIT_V(8); PG8_WAIT_L(0); PG8_BAR; PG8_MMA(1, 0, At, B0); PG8_MMA(1, 1, At, B1); PG8_BAR; PG8_SCHED;
            PG8_LDB(B0, 1, 0); PG8_LDB(B1, 1, 1); PG8_SCHED; PG8_LDA(At, 1, 0); PG8_STAGE(PG8_SA(0, 1), a2 + hstep, voffA);
            PG8_WAIT_V(8); PG8_WAIT_L(0); PG8_BAR; PG8_MMA(0, 0, At, B0); PG8_MMA(0, 1, At, B1); PG8_BAR; PG8_SCHED;
            PG8_LDA(At, 1, 1); PG8_STAGE(PG8_SB(1, 0), b3, voffB); PG8_STAGE(PG8_SB(1, 1), b3 + hstep, voffB); PG8_STAGE(PG8_SA(1, 0), a3, voffA);
            PG8_WAIT_V(8); PG8_WAIT_L(0); PG8_BAR; PG8_MMA(1, 0, At, B0); PG8_MMA(1, 1, At, B1); PG8_BAR; PG8_SCHED;
            } else {
            PG8_LDB(B0, 0, 0); PG8_SCHED; PG8_LDA(At, 0, 0); PG8_STAGE(PG8_SA(1, 1), a1 + hstep, voffA);
            PG8_WAIT_L(8); PG8_BAR; PG8_WAIT_L(0); PG8_MMA(0, 0, At, B0); PG8_BAR; PG8_SCHED;
            PG8_LDB(B1, 0, 1); PG8_STAGE(PG8_SB(0, 0), b2, voffB);
            PG8_BAR; PG8_WAIT_L(0); PG8_MMA(0, 1, At, B1); PG8_BAR;
            PG8_LDA(At, 0, 1); PG8_STAGE(PG8_SA(0, 0), a2, voffA);
            PG8_BAR; PG8_WAIT_L(0); PG8_MMA(1, 0, At, B0); PG8_BAR; PG8_SCHED;
            PG8_STAGE(PG8_SB(0, 1), b2 + hstep, voffB);
            PG8_WAIT_V(6); PG8_BAR; PG8_MMA(1, 1, At, B1); PG8_BAR;
            PG8_LDB(B0, 1, 0); PG8_SCHED; PG8_LDA(At, 1, 0); PG8_STAGE(PG8_SA(0, 1), a2 + hstep, voffA);
            PG8_WAIT_L(8); PG8_BAR; PG8_WAIT_L(0); PG8_MMA(0, 0, At, B0); PG8_BAR; PG8_SCHED;
            PG8_LDB(B1, 1, 1); PG8_STAGE(PG8_SB(1, 0), b3, voffB);
            PG8_BAR; PG8_WAIT_L(0); PG8_MMA(0, 1, At, B1); PG8_BAR;
            PG8_LDA(At, 1, 1); PG8_STAGE(PG8_SA(1, 0), a3, voffA);
            PG8_BAR; PG8_WAIT_L(0); PG8_MMA(1, 0, At, B0); PG8_BAR; PG8_SCHED;
            PG8_STAGE(PG8_SB(1, 1), b3 + hstep, voffB);
            PG8_WAIT_V(6); PG8_BAR; PG8_MMA(1, 1, At, B1); PG8_BAR;
            }
        }
        if constexpr (ALIGN_EPI) { if (wr == 0) PG8_BAR; }
        if constexpr (!Epi::AFTER_DRAIN) { E(acc, cur, wr, wc, fr, fq); S.done(cur); }
        if (!has_next) break;
#pragma unroll
        for (int a = 0; a < 2; ++a)
#pragma unroll
            for (int b = 0; b < 2; ++b)
#pragma unroll
                for (int m = 0; m < 4; ++m)
#pragma unroll
                    for (int n = 0; n < 2; ++n) acc[a][b][m][n] = (f32x4){0.f, 0.f, 0.f, 0.f};
        cur = nxt; cA = nA; cB = nB; ++ui;
        if constexpr (ALIGN_EPI) { if (wr == 1) PG8_BAR; }
    }
    PG8_WAIT_V(0);
    if constexpr (!ALIGN_EPI) { if (wr == 0) PG8_BAR; }
    PG8_BAR;
    if constexpr (Epi::AFTER_DRAIN) { E.fused(acc, cur, wr, wc, fr, fq, lds, wid, lane); S.done(cur); }
#undef PG8_SA
#undef PG8_SB
#undef PG8_STAGE
#undef PG8_LDA
#undef PG8_LDB
#undef PG8_MMA
#undef PG8_WAIT_V
#undef PG8_WAIT_L
#undef PG8_BAR
#undef PG8_SCHED
}
}
#ifndef PG8_SP2
#define PG8_SP2 true
#endif
#ifndef PG8_ALIGN
#define PG8_ALIGN true
#endif
constexpr int NB = 4, SEQ = 4096, T = NB * SEQ, DM = 1024, FF = 2816, NMOD = 9 * DM;
constexpr float EPS = 1e-6f;
constexpr float LOG2E = 1.4426950408889634f;
constexpr int NWAVES = 8, NTHR = 512;
constexpr int LDS_MAIN = 131072;
constexpr int LDS_BYTES = LDS_MAIN + 64;

#define LAS __attribute__((address_space(3)))
#define GAS __attribute__((address_space(1)))
typedef unsigned short bf16;
typedef short bf16x8 __attribute__((ext_vector_type(8)));
typedef short s16x4 __attribute__((ext_vector_type(4)));
typedef float f32x2 __attribute__((ext_vector_type(2)));
typedef float f32x4 __attribute__((ext_vector_type(4)));
typedef float f32x16 __attribute__((ext_vector_type(16)));
typedef unsigned u32x2 __attribute__((ext_vector_type(2)));
typedef unsigned u32x4 __attribute__((ext_vector_type(4)));
typedef __bf16 bf16x2_t __attribute__((ext_vector_type(2)));

constexpr size_t MiB = 1u << 20;
constexpr size_t WS_CTL = 0, CTL_ZERO_BYTES = 16384;
constexpr size_t WS_SSQ = 64 * 1024;
constexpr size_t WS_WGU = 1 * MiB;
constexpr size_t WS_WD = 45 * MiB;
constexpr size_t WS_WIN_E = 67 * MiB;
constexpr size_t WS_WQB = WS_WIN_E + 7680 * 1024;
constexpr size_t WS_WKVB = WS_WQB + 768 * 1024;
constexpr size_t WS_WOUT_E = 76 * MiB;
constexpr size_t WS_WIN_O = 80 * MiB;
constexpr size_t WS_WOUT_O = WS_WIN_O + 8704 * 1024;
constexpr size_t WS_MOD = 91 * MiB;
constexpr size_t WS_BIASV = WS_MOD + 512 * 1024;
constexpr int BV_IN_E = 4 * 4 * 5632, BV_IN_O = BV_IN_E + 4 * 3840;
constexpr size_t WS_CUM = 92 * MiB;
constexpr size_t WS_FLOG = 93 * MiB;
constexpr size_t WS_A = 94 * MiB;
constexpr size_t WS_C = 158 * MiB;
constexpr size_t WS_LAT = WS_C, WS_CQN = WS_C + 24 * MiB, WS_CKVN = WS_C + 36 * MiB, WS_OG = WS_C;
constexpr size_t WS_QAUG = WS_C + 32 * MiB, WS_KAUG = WS_C + 36 * MiB;
constexpr size_t WS_B = 202 * MiB;
constexpr size_t WS_KH = WS_B + 32 * MiB;
constexpr size_t WS_ACT = WS_B, WS_QK = WS_B, WS_VA = WS_B + 64 * MiB, WS_QB = WS_B, WS_KVB = WS_B + 24 * MiB, WS_KB = WS_B + 72 * MiB;
constexpr size_t WS_END = 298 * MiB;

__device__ __forceinline__ float bf2f(bf16 v) { return __uint_as_float((unsigned)v << 16); }
__device__ __forceinline__ unsigned pk2(float lo, float hi) { f32x2 v = {lo, hi}; bf16x2_t b = __builtin_convertvector(v, bf16x2_t); return __builtin_bit_cast(unsigned, b); }
__device__ __forceinline__ bf16 f2bf(float f) { return (bf16)(pk2(f, 0.f) & 0xffffu); }
__device__ __forceinline__ float wave_sum(float v) {
#pragma unroll
    for (int o = 1; o < 64; o <<= 1) v += __shfl_xor(v, o);
    return v;
}
__device__ __forceinline__ float half_sum(float v) {
#pragma unroll
    for (int o = 1; o < 32; o <<= 1) v += __shfl_xor(v, o);
    return v;
}
__device__ __forceinline__ float fexp2(float x) { return __builtin_amdgcn_exp2f(x); }
__device__ __forceinline__ float sigmoidf_(float x) { return __builtin_amdgcn_rcpf(1.0f + fexp2(-x * LOG2E)); }
__device__ __forceinline__ int crow(int i, int h) { return (i & 3) + 8 * (i >> 2) + 4 * h; }
#define LDS_WAIT() asm volatile("s_waitcnt lgkmcnt(0)" ::: "memory")
__device__ __forceinline__ float bf16r(float x) { return __uint_as_float(pk2(x, 0.f) << 16); }
__device__ __forceinline__ void split3(float x, float& hi, float& mid, float& lo) { hi = bf16r(x); const float r1 = x - hi; mid = bf16r(r1); lo = bf16r(r1 - mid); }
__device__ __forceinline__ bf16x8 split3frag(float x) { float a, b, c; split3(x, a, b, c); u32x4 w; w.x = pk2(a, b); w.y = pk2(c, 0.f); w.z = 0u; w.w = 0u; return __builtin_bit_cast(bf16x8, w); }

__device__ __forceinline__ float row_rinv(const float* __restrict__ ssq, int row) {
    const f32x4 q = *(const f32x4*)(ssq + (size_t)row * 4);
    return __builtin_amdgcn_rsqf(((q.x + q.y) + (q.z + q.w)) * (1.0f / DM) + EPS);
}
struct EpiSwiglu {
    static constexpr bool PERM = true, AFTER_DRAIN = false;
    bf16* O; int ldc; const float* ssq; const float* bias;
    __device__ __forceinline__ void operator()(const pg8::f32x4 (&acc)[2][2][4][2], const pg8::Unit& u, int wr, int wc, int fr, int fq) const {
        const int row0 = u.pm * 256 + wr * 64 + fr, col0 = u.pn * 128 + wc * 32 + 8 * fq;
        const float* bp = bias + (size_t)(u.pm >> 4) * 5632 + u.pn * 256 + wc * 32 + 8 * fq;
        const f32x4 bg0 = *(const f32x4*)bp, bg1 = *(const f32x4*)(bp + 4), bu0 = *(const f32x4*)(bp + 128), bu1 = *(const f32x4*)(bp + 132);
#pragma unroll
        for (int ai = 0; ai < 2; ++ai)
#pragma unroll
            for (int m = 0; m < 4; ++m) {
                const int row = row0 + ai * 128 + m * 16;
                const float rinv = row_rinv(ssq, row);
                bf16* rowp = O + (size_t)row * ldc + col0;
                float v[8];
#pragma unroll
                for (int n = 0; n < 2; ++n)
#pragma unroll
                    for (int e = 0; e < 4; ++e) {
                        const float g = acc[ai][0][m][n][e] * rinv + (n == 0 ? bg0[e] : bg1[e]), up = acc[ai][1][m][n][e] * rinv + (n == 0 ? bu0[e] : bu1[e]);
                        v[4 * n + e] = g * sigmoidf_(g) * up;
                    }
                u32x4 w; w.x = pk2(v[0], v[1]); w.y = pk2(v[2], v[3]); w.z = pk2(v[4], v[5]); w.w = pk2(v[6], v[7]);
                *(u32x4*)rowp = w;
            }
    }
};
struct EpiResid {
    static constexpr bool PERM = false, AFTER_DRAIN = true;
    unsigned char* ws; const float* x0; float* xbuf; int code;
    __device__ __forceinline__ void fused(pg8::f32x4 (&acc)[2][2][4][2], const pg8::Unit& u, int wr, int wc, int fr, int fq, LAS unsigned char* lds, int wid, int lane) const {
        const bool isdown = code & 1; const int sub = (code >> 1) & 1, l = code >> 2;
        const float* modl = (const float*)(ws + WS_MOD) + (size_t)l * 4 * NMOD;
        const float* scn = !isdown ? modl + 7 * DM : (sub == 0 ? modl + 4 * DM : (l == 0 ? modl + 4 * NMOD + 1 * DM : nullptr));
        const float* xin = (isdown && l == 0 && sub == 0) ? x0 : xbuf; float* xout = xbuf;
        const float* g = modl + (isdown ? (sub == 0 ? 2 : 8) : 5) * DM;
        const float coef = isdown ? 0.5f : 1.0f;
        bf16* xt = (bf16*)(ws + (isdown ? WS_A : WS_C)); float* ssq = (float*)(ws + WS_SSQ);
        const int b = u.pm >> 4, col0 = u.pn * 256 + wc * 32 + 4 * fq;
        const bool nxt = scn != nullptr;
        f32x4 gv[2][2], sv[2][2];
#pragma unroll
        for (int bj = 0; bj < 2; ++bj)
#pragma unroll
            for (int n = 0; n < 2; ++n) {
                gv[bj][n] = *(const f32x4*)(g + (size_t)b * NMOD + col0 + bj * 128 + n * 16) * coef;
                sv[bj][n] = nxt ? (*(const f32x4*)(scn + (size_t)b * NMOD + col0 + bj * 128 + n * 16) + 1.0f) : (f32x4){0.f, 0.f, 0.f, 0.f};
            }
        LAS float* P = (LAS float*)lds;
#pragma unroll
        for (int ai = 0; ai < 2; ++ai) {
            f32x4 xi[4][2][2];
#pragma unroll
            for (int m = 0; m < 4; ++m) {
                const size_t off = (size_t)(u.pm * 256 + ai * 128 + wr * 64 + m * 16 + fr) * DM + col0;
#pragma unroll
                for (int bj = 0; bj < 2; ++bj)
#pragma unroll
                    for (int n = 0; n < 2; ++n) xi[m][bj][n] = *(const f32x4*)(xin + off + bj * 128 + n * 16);
            }
            asm volatile("" ::: "memory");
#pragma unroll
            for (int m = 0; m < 4; ++m) {
                const int rl = ai * 128 + wr * 64 + m * 16 + fr;
                const size_t off = (size_t)(u.pm * 256 + rl) * DM + col0;
                float s = 0.f;
#pragma unroll
                for (int bj = 0; bj < 2; ++bj)
#pragma unroll
                    for (int n = 0; n < 2; ++n) {
                        const f32x4 xn = xi[m][bj][n] + gv[bj][n] * acc[ai][bj][m][n];
                        *(f32x4*)(xout + off + bj * 128 + n * 16) = xn;
                        if (nxt) {
                            s += (xn.x * xn.x + xn.y * xn.y) + (xn.z * xn.z + xn.w * xn.w);
                            const f32x4 y = xn * sv[bj][n];
                            u32x2 w; w.x = pk2(y.x, y.y); w.y = pk2(y.z, y.w);
                            *(u32x2*)(xt + off + bj * 128 + n * 16) = w;
                        }
                    }
                if (nxt) { s += __shfl_xor(s, 16); s += __shfl_xor(s, 32); if (fq == 0) P[rl * 4 + wc] = s; }
            }
        }
        if (nxt) {
            __syncthreads();
            const int t = wid * 64 + lane;
            if (t < 256) { const f32x4 p = *(LAS const f32x4*)(P + t * 4); ssq[(size_t)(u.pm * 256 + t) * 4 + u.pn] = (p.x + p.y) + (p.z + p.w); }
        }
    }
};
struct EpiStore {
    static constexpr bool PERM = true, AFTER_DRAIN = false;
    bf16 *b0, *b1, *b2, *b3; int l0, l1, l2, l3, t1, t2, t3, ft; float* fb; const float* ssq; const float* bias; int bn;
    int hm;
    __device__ __forceinline__ void operator()(const pg8::f32x4 (&acc)[2][2][4][2], const pg8::Unit& u, int wr, int wc, int fr, int fq) const {
        const int pn = u.pn, row0 = u.pm * 256 + wr * 64 + fr;
        const bool modn = ssq != nullptr;
        const float* bp = bias + (size_t)(u.pm >> 4) * bn + pn * 256 + wc * 32 + 8 * fq;
        pg8::f32x4 bv[2][2];
#pragma unroll
        for (int bj = 0; bj < 2; ++bj)
#pragma unroll
            for (int n = 0; n < 2; ++n) bv[bj][n] = modn ? *(const pg8::f32x4*)(bp + bj * 128 + 4 * n) : (pg8::f32x4){0.f, 0.f, 0.f, 0.f};
        if (pn == ft) {
            if (wc == 0 && fq < 2) {
#pragma unroll
                for (int ai = 0; ai < 2; ++ai)
#pragma unroll
                    for (int m = 0; m < 4; ++m) {
                        const int row = row0 + ai * 128 + m * 16; const float rinv = modn ? row_rinv(ssq, row) : 1.0f;
#pragma unroll
                        for (int n = 0; n < 2; ++n) *(pg8::f32x4*)(fb + (size_t)row * 16 + 8 * fq + 4 * n) = acc[ai][0][m][n] * rinv + bv[0][n];
                    }
            }
            return;
        }
        bf16* base; int ldc, ts, hd;
        if (pn < t1) { base = b0; ldc = l0; ts = 0; hd = hm & 255; } else if (pn < t2) { base = b1; ldc = l1; ts = t1; hd = (hm >> 8) & 255; } else if (pn < t3) { base = b2; ldc = l2; ts = t2; hd = (hm >> 16) & 255; } else { base = b3; ldc = l3; ts = t3; hd = (hm >> 24) & 255; }
        const int col0 = (pn - ts) * 256 + wc * 32 + 8 * fq;
        size_t coff[2];
#pragma unroll
        for (int bj = 0; bj < 2; ++bj) { const int c = col0 + bj * 128; if (hd == 0) coff[bj] = (size_t)c; else { const int head = c / hd; coff[bj] = (size_t)head * SEQ * hd + (c - head * hd); } }
#pragma unroll
        for (int ai = 0; ai < 2; ++ai)
#pragma unroll
            for (int m = 0; m < 4; ++m) {
                const int row = row0 + ai * 128 + m * 16; const float rinv = modn ? row_rinv(ssq, row) : 1.0f;
                bf16* rowp = base + (hd == 0 ? (size_t)row * ldc : (size_t)(row >> 12) * SEQ * ldc + (size_t)(row & (SEQ - 1)) * hd);
#pragma unroll
                for (int bj = 0; bj < 2; ++bj) {
                    const pg8::f32x4 v0 = acc[ai][bj][m][0] * rinv + bv[bj][0], v1 = acc[ai][bj][m][1] * rinv + bv[bj][1];
                    u32x4 w; w.x = pk2(v0[0], v0[1]); w.y = pk2(v0[2], v0[3]); w.z = pk2(v1[0], v1[1]); w.w = pk2(v1[2], v1[3]);
                    *(u32x4*)(rowp + coff[bj]) = w;
                }
            }
    }
};

__device__ __forceinline__ void transpose_item(const float* __restrict__ W, int K, int ldw, int nblk, bf16* __restrict__ WT, int mode, LAS float* scr, int item, int lane) {
    const int kb = item / nblk, nb = item - kb * nblk, k0 = 64 * kb, n0 = 32 * nb;
#pragma unroll 8
    for (int i = 0; i < 32; ++i) { const int kk = 2 * i + (lane >> 5); scr[kk * 33 + (lane & 31)] = W[(size_t)(k0 + kk) * ldw + n0 + (lane & 31)]; }
    LDS_WAIT();
    const int c = lane & 7;
#pragma unroll
    for (int j = 0; j < 4; ++j) {
        const int n = (lane >> 3) + 8 * j, gn = n0 + n;
        const int row = mode == 0 ? gn : ((gn >> 7) * 256 + (gn & 127) + (mode == 2 ? 128 : 0));
        const LAS float* s = scr + (8 * c) * 33 + n;
        u32x4 o; o.x = pk2(s[0 * 33], s[1 * 33]); o.y = pk2(s[2 * 33], s[3 * 33]); o.z = pk2(s[4 * 33], s[5 * 33]); o.w = pk2(s[6 * 33], s[7 * 33]);
        *(u32x4*)(WT + (size_t)row * K + k0 + 8 * c) = o;
    }
    LDS_WAIT();
}

struct Args { const float* in[31]; float* out; unsigned char* ws; int ph_lo, ph_hi; };
struct Ctx { int tid, bid, G, zi; unsigned char* ws; };
#define INP(k) (a.in[(k) + cx.zi])

__device__ __forceinline__ void prologue_phase(const Args& a, const Ctx& cx, LAS unsigned char* lds) {
    unsigned char* ws = cx.ws;
    const int tid = cx.tid, lane = tid & 63, wave = tid >> 6, G = cx.G;
    const int gw = cx.bid * NWAVES + wave, NGW = G * NWAVES;
    LAS float* scr = (LAS float*)(lds + wave * 8704);
    constexpr int I_FF = 1408, N_FF = 12 * I_FF;
    constexpr int I_INE = 16 * 117, I_QB = 6 * 24, I_KVB = 4 * 48, I_OUTE = 32 * 32, I_INO = 16 * 128, I_OUTO = 16 * 32;
    constexpr int NITEMS = N_FF + I_INE + I_QB + I_KVB + I_OUTE + I_INO + I_OUTO;
    for (int it = gw; it < NITEMS; it += NGW) {
        int r = it;
        if (r < N_FF) {
            const int id = r / I_FF, item = r - id * I_FF, lf = id / 3, which = id - lf * 3, l = lf >> 1, f = lf & 1;
            if (which < 2) transpose_item(INP(5 + f * 3 + which) + (size_t)l * DM * FF, DM, FF, FF / 32, (bf16*)(ws + WS_WGU) + (size_t)lf * 5632 * 1024, 1 + which, scr, item, lane);
            else transpose_item(INP(7 + f * 3) + (size_t)l * FF * DM, FF, DM, DM / 32, (bf16*)(ws + WS_WD) + (size_t)lf * 1024 * 2816, 0, scr, item, lane);
            continue;
        }
        r -= N_FF;
        if (r < I_INE) { transpose_item(INP(11), 1024, 3744, 117, (bf16*)(ws + WS_WIN_E), 0, scr, r, lane); continue; } r -= I_INE;
        if (r < I_QB) { transpose_item(INP(12), 384, 768, 24, (bf16*)(ws + WS_WQB), 0, scr, r, lane); continue; } r -= I_QB;
        if (r < I_KVB) { transpose_item(INP(13), 256, 1536, 48, (bf16*)(ws + WS_WKVB), 0, scr, r, lane); continue; } r -= I_KVB;
        if (r < I_OUTE) { transpose_item(INP(25), 2048, 1024, 32, (bf16*)(ws + WS_WOUT_E), 0, scr, r, lane); continue; } r -= I_OUTE;
        if (r < I_INO) { transpose_item(INP(26), 1024, 4112, 128, (bf16*)(ws + WS_WIN_O), 0, scr, r, lane); continue; } r -= I_INO;
        transpose_item(INP(30), 1024, 1024, 32, (bf16*)(ws + WS_WOUT_O), 0, scr, r, lane);
    }
    for (int i = cx.bid * NTHR + tid; i < 16 * 1024; i += G * NTHR) { const int n = i >> 10, k = i & 1023; ((bf16*)(ws + WS_WIN_O))[(size_t)(4096 + n) * 1024 + k] = f2bf(INP(26)[(size_t)k * 4112 + 4096 + n]); }
    __syncthreads();
    LAS float* sc = (LAS float*)(lds + 73728);
    LAS float* part = (LAS float*)(lds + 90112);
    for (int bi = cx.bid; bi < 144; bi += G) {
        const int l = bi / 72, n0 = (bi - l * 72) * 128;
        for (int i = tid; i < 4096; i += NTHR) { const float v = INP(1)[i]; sc[i] = v * sigmoidf_(v); }
        __syncthreads();
        float acc[4][2];
#pragma unroll
        for (int b = 0; b < 4; ++b) { acc[b][0] = 0.f; acc[b][1] = 0.f; }
        const float* wp = INP(3) + ((size_t)l * 1024 + wave * 128) * NMOD + n0 + 2 * lane;
#pragma unroll 8
        for (int k = 0; k < 128; ++k) {
            const f32x2 wv = *(const f32x2*)(wp + (size_t)k * NMOD);
#pragma unroll
            for (int b = 0; b < 4; ++b) { const float s = sc[b * 1024 + wave * 128 + k]; acc[b][0] += s * wv.x; acc[b][1] += s * wv.y; }
        }
#pragma unroll
        for (int b = 0; b < 4; ++b) { part[(wave * 4 + b) * 128 + 2 * lane] = acc[b][0]; part[(wave * 4 + b) * 128 + 2 * lane + 1] = acc[b][1]; }
        __syncthreads();
        { const int b = tid >> 7, col = tid & 127; float s = INP(4)[(size_t)l * NMOD + n0 + col];
#pragma unroll
          for (int w = 0; w < 8; ++w) s += part[(w * 4 + b) * 128 + col];
          ((float*)(ws + WS_MOD))[(size_t)(l * 4 + b) * NMOD + n0 + col] = s; }
        __syncthreads();
    }
}

__device__ __forceinline__ void mod0_phase(const Args& a, const Ctx& cx) {
    unsigned char* ws = cx.ws;
    const int tid = cx.tid, lane = tid & 63, wave = tid >> 6;
    const int gw = cx.bid * NWAVES + wave, NGW = cx.G * NWAVES;
    const float* x = INP(0); const float* mod = (const float*)(ws + WS_MOD);
    bf16* XT = (bf16*)(ws + WS_A); float* ssq = (float*)(ws + WS_SSQ);
    for (int row = gw; row < T; row += NGW) {
        const int b = row >> 12;
        const float* scp = mod + (size_t)b * NMOD + DM;
        const f32x4* xr = (const f32x4*)(x + (size_t)row * DM) + lane;
        f32x4 v[4]; float ss = 0.f;
#pragma unroll
        for (int j = 0; j < 4; ++j) { v[j] = xr[64 * j]; ss += (v[j].x * v[j].x + v[j].y * v[j].y) + (v[j].z * v[j].z + v[j].w * v[j].w); }
        ss = wave_sum(ss);
        if (lane == 0) *(f32x4*)(ssq + (size_t)row * 4) = (f32x4){ss, 0.f, 0.f, 0.f};
        u32x2* o8 = (u32x2*)(XT + (size_t)row * DM) + lane;
#pragma unroll
        for (int j = 0; j < 4; ++j) {
            const f32x4 s4 = *((const f32x4*)scp + lane + 64 * j);
            const f32x4 y = v[j] * (s4 + 1.0f);
            u32x2 w; w.x = pk2(y.x, y.y); w.y = pk2(y.z, y.w); o8[64 * j] = w;
        }
    }
    for (int mi = 0; mi < 6; ++mi) {
        const int l = mi / 3, w3 = mi - l * 3;
        const bf16* Wt; int N; float* out;
        if (w3 == 1) { Wt = (const bf16*)(ws + (l == 0 ? WS_WIN_E : WS_WIN_O)); N = l == 0 ? 3840 : 4352; out = (float*)(ws + WS_BIASV) + (l == 0 ? BV_IN_E : BV_IN_O); }
        else { const int lf = l * 2 + (w3 >> 1); Wt = (const bf16*)(ws + WS_WGU) + (size_t)lf * 5632 * 1024; N = 5632; out = (float*)(ws + WS_BIASV) + (size_t)lf * 4 * 5632; }
        f32x4 sh[4][4];
#pragma unroll
        for (int b = 0; b < 4; ++b)
#pragma unroll
            for (int j = 0; j < 4; ++j) sh[b][j] = *(const f32x4*)(mod + (size_t)(l * 4 + b) * NMOD + (3 * w3) * DM + 16 * lane + 4 * j);
        for (int n = gw; n < N; n += NGW) {
            const u32x4 w0 = *(const u32x4*)(Wt + (size_t)n * 1024 + 16 * lane), w1 = *(const u32x4*)(Wt + (size_t)n * 1024 + 16 * lane + 8);
            float wf[16];
#pragma unroll
            for (int e = 0; e < 4; ++e) { wf[2 * e] = __uint_as_float(w0[e] << 16); wf[2 * e + 1] = __uint_as_float(w0[e] & 0xffff0000u); wf[8 + 2 * e] = __uint_as_float(w1[e] << 16); wf[8 + 2 * e + 1] = __uint_as_float(w1[e] & 0xffff0000u); }
            float acc[4];
#pragma unroll
            for (int b = 0; b < 4; ++b) { float s = 0.f;
#pragma unroll
                for (int j = 0; j < 4; ++j) s += (sh[b][j].x * wf[4 * j] + sh[b][j].y * wf[4 * j + 1]) + (sh[b][j].z * wf[4 * j + 2] + sh[b][j].w * wf[4 * j + 3]);
                acc[b] = wave_sum(s); }
            if (lane == 0) {
#pragma unroll
                for (int b = 0; b < 4; ++b) out[(size_t)b * N + n] = acc[b];
            }
        }
    }
}

__constant__ const double ROPE_REV64[32] = {0.15915494309189535, 0.11934937021124886, 0.08949940160889101, 0.06711508300522726, 0.050329212104487035, 0.03774158471741977, 0.0283021958306234, 0.02122365276477766, 0.015915494309189534, 0.011934937021124886, 0.008949940160889102, 0.006711508300522725, 0.005032921210448704, 0.003774158471741977, 0.00283021958306234, 0.0021223652764777662, 0.0015915494309189536, 0.0011934937021124885, 0.0008949940160889102, 0.0006711508300522726, 0.0005032921210448703, 0.00037741584717419774, 0.00028302195830623395, 0.0002122365276477766, 0.00015915494309189535, 0.00011934937021124886, 8.949940160889102e-05, 6.711508300522725e-05, 5.0329212104487035e-05, 3.774158471741978e-05, 2.8302195830623396e-05, 2.122365276477766e-05};
__constant__ const double ROPE_REV32[16] = {0.15915494309189535, 0.08949940160889101, 0.050329212104487035, 0.0283021958306234, 0.015915494309189534, 0.008949940160889102, 0.005032921210448704, 0.00283021958306234, 0.0015915494309189536, 0.0008949940160889102, 0.0005032921210448703, 0.00028302195830623395, 0.00015915494309189535, 8.949940160889102e-05, 5.0329212104487035e-05, 2.8302195830623396e-05};
__device__ __forceinline__ void rope_cs(int pos, int i, int dim, float& c, float& s) {
    const double rev = (double)pos * (dim == 64 ? ROPE_REV64[i] : ROPE_REV32[i]);
    const float fr = (float)__builtin_amdgcn_fract(rev);
    s = __builtin_amdgcn_sinf(fr); c = __builtin_amdgcn_cosf(fr);
}

__device__ __forceinline__ void unpack8(const u32x4 w, float (&x)[8]) {
#pragma unroll
    for (int e = 0; e < 4; ++e) { x[2 * e] = __uint_as_float(w[e] << 16); x[2 * e + 1] = __uint_as_float(w[e] & 0xffff0000u); }
}
__device__ __forceinline__ u32x4 pack8(const float (&x)[8]) { u32x4 w; w.x = pk2(x[0], x[1]); w.y = pk2(x[2], x[3]); w.z = pk2(x[4], x[5]); w.w = pk2(x[6], x[7]); return w; }
template <bool ROPE>
__device__ __forceinline__ void prep_qk_token(bf16* __restrict__ qk, const float* __restrict__ gq, const float* __restrict__ gk, float qscale, int pos, int lane) {
    const int cc = lane & 7;
    float cs[8], sn[8], gqv[8], gkv[8];
#pragma unroll
    for (int e = 0; e < 8; ++e) { gqv[e] = gq[8 * cc + e]; gkv[e] = gk[8 * cc + e]; cs[e] = 1.f; sn[e] = 0.f; if (ROPE) rope_cs(pos, (8 * cc + e) & 31, 64, cs[e], sn[e]); }
    u32x4 raw[4];
#pragma unroll
    for (int j = 0; j < 4; ++j) raw[j] = *((const u32x4*)qk + lane + 64 * j);
#pragma unroll
    for (int j = 0; j < 4; ++j) {
        u32x4* p = (u32x4*)qk + lane + 64 * j;
        float x[8]; unpack8(raw[j], x);
        float ss = 0.f;
#pragma unroll
        for (int e = 0; e < 8; ++e) ss += x[e] * x[e];
        ss += __shfl_xor(ss, 1); ss += __shfl_xor(ss, 2); ss += __shfl_xor(ss, 4);
        const float rinv = __builtin_amdgcn_rsqf(ss * (1.0f / 64.0f) + EPS);
        const bool isq = j < 2;
        float o[8];
#pragma unroll
        for (int e = 0; e < 8; ++e) {
            const float y = x[e] * rinv * (isq ? gqv[e] : gkv[e]);
            float r = y;
            if (ROPE) { const float pr = __shfl_xor(y, 4); r = (cc < 4) ? (y * cs[e] - pr * sn[e]) : (y * cs[e] + pr * sn[e]); }
            o[e] = isq ? r * qscale : r;
        }
        *p = pack8(o);
    }
}

__device__ __forceinline__ void prep1e_phase(const Args& a, const Ctx& cx) {
    unsigned char* ws = cx.ws;
    const int tid = cx.tid, lane = tid & 63, wave = tid >> 6;
    const int gw = cx.bid * NWAVES + wave, NGW = cx.G * NWAVES;
    const int* positions = (const int*)INP(2);
    const float qscale = 0.125f * LOG2E;
    for (int t = gw; t < T; t += NGW) {
        const u32x4* lat = (const u32x4*)((const bf16*)(ws + WS_LAT) + (size_t)t * 768);
        const u32x4 lq = lat[lane < 48 ? lane : 0], lkv = lat[48 + (lane & 31)];
        prep_qk_token<true>((bf16*)(ws + WS_QK) + (size_t)t * 2048, INP(16), INP(17), qscale, positions[t], lane);
        {
            float x[8]; float ss = 0.f;
            if (lane < 48) { unpack8(lq, x);
#pragma unroll
                for (int e = 0; e < 8; ++e) ss += x[e] * x[e]; }
            const float rinv = __builtin_amdgcn_rsqf(wave_sum(ss) * (1.0f / 384.0f) + EPS);
            if (lane < 48) { float o[8];
#pragma unroll
                for (int e = 0; e < 8; ++e) o[e] = x[e] * rinv * INP(14)[8 * lane + e];
                ((u32x4*)((bf16*)(ws + WS_CQN) + (size_t)t * 384))[lane] = pack8(o); }
        }
        {
            float x[8]; float ss = 0.f;
            if (lane < 32) { unpack8(lkv, x);
#pragma unroll
                for (int e = 0; e < 8; ++e) ss += x[e] * x[e]; }
            const float rinv = __builtin_amdgcn_rsqf(wave_sum(ss) * (1.0f / 256.0f) + EPS);
            if (lane < 32) { float o[8];
#pragma unroll
                for (int e = 0; e < 8; ++e) o[e] = x[e] * rinv * INP(15)[8 * lane + e];
                ((u32x4*)((bf16*)(ws + WS_CKVN) + (size_t)t * 256))[lane] = pack8(o); }
        }
    }
}

__device__ __forceinline__ void prep2e_phase(const Args& a, const Ctx& cx) {
    unsigned char* ws = cx.ws;
    const int tid = cx.tid, lane = tid & 63, wave = tid >> 6;
    const int gw = cx.bid * NWAVES + wave, NGW = cx.G * NWAVES;
    const int* positions = (const int*)INP(2);
    const int cl = lane & 15, grp = lane >> 4;
    const bool act = cl < 12, isr = cl >= 8;
    const float qscale = 0.10206207261596575f * LOG2E;
    float gqv[8], gkv[8];
#pragma unroll
    for (int e = 0; e < 8; ++e) { gqv[e] = act ? INP(18)[8 * cl + e] : 0.f; gkv[e] = act ? INP(19)[8 * cl + e] : 0.f; }
    for (int t = gw; t < T; t += NGW) {
        const int pos = positions[t];
        float cs[8], sn[8];
#pragma unroll
        for (int e = 0; e < 8; ++e) rope_cs(pos, 8 * (cl & 1) + e, 32, cs[e], sn[e]);
        bf16* qb = (bf16*)(ws + WS_QB) + (size_t)t * 768;
        const bf16* kvb = (const bf16*)(ws + WS_KVB) + (size_t)t * 1536;
        const bf16* lat = (const bf16*)(ws + WS_LAT) + (size_t)t * 768;
        bf16* kbo = (bf16*)(ws + WS_KB) + (size_t)t * 768;
        u32x4 raw[2][2];
#pragma unroll
        for (int j = 0; j < 2; ++j)
#pragma unroll
            for (int qk = 0; qk < 2; ++qk) {
                const int head = 4 * j + grp;
                raw[j][qk] = (u32x4){0u, 0u, 0u, 0u};
                if (act) {
                    if (qk == 0) raw[j][qk] = *(const u32x4*)(qb + head * 96 + 8 * cl);
                    else if (!isr) raw[j][qk] = *(const u32x4*)(kvb + head * 192 + 8 * cl);
                    else raw[j][qk] = *(const u32x4*)(lat + 640 + 8 * (cl - 8));
                }
            }
#pragma unroll
        for (int j = 0; j < 2; ++j) {
            const int head = 4 * j + grp;
#pragma unroll
            for (int qk = 0; qk < 2; ++qk) {
                float x[8]; unpack8(raw[j][qk], x);
                float ss = 0.f;
#pragma unroll
                for (int e = 0; e < 8; ++e) ss += x[e] * x[e];
                ss += __shfl_xor(ss, 1); ss += __shfl_xor(ss, 2); ss += __shfl_xor(ss, 4); ss += __shfl_xor(ss, 8);
                const float rinv = __builtin_amdgcn_rsqf(ss * (1.0f / 96.0f) + EPS);
                float o[8];
#pragma unroll
                for (int e = 0; e < 8; ++e) {
                    const float y = x[e] * rinv * (qk == 0 ? gqv[e] : gkv[e]);
                    const float pr = __shfl_xor(y, 2);
                    float r = y;
                    if (isr) r = (cl < 10) ? (y * cs[e] - pr * sn[e]) : (y * cs[e] + pr * sn[e]);
                    o[e] = qk == 0 ? r * qscale : r;
                }
                if (act) { if (qk == 0) *(u32x4*)(qb + head * 96 + 8 * cl) = pack8(o); else *(u32x4*)(kbo + head * 96 + 8 * cl) = pack8(o); }
            }
        }
    }
}

__device__ __forceinline__ void prepo_phase(const Args& a, const Ctx& cx, LAS unsigned char* lds) {
    unsigned char* ws = cx.ws;
    const int tid = cx.tid, lane = tid & 63, wave = tid >> 6;
    const int gw = cx.bid * NWAVES + wave, NGW = cx.G * NWAVES;
    const float qscale = 0.125f * LOG2E;
    {
        const int cc = lane & 7;
        float gqv[8], gkv[8];
#pragma unroll
        for (int e = 0; e < 8; ++e) { gqv[e] = INP(28)[8 * cc + e] * qscale; gkv[e] = INP(29)[8 * cc + e]; }
        for (int t = gw; t < T; t += NGW) {
            const int b = t >> 12, sq_ = t & (SEQ - 1);
            u32x4* pp[4]; u32x4 raw[4];
#pragma unroll
            for (int j = 0; j < 4; ++j) {
                const int v = (lane >> 3) + 8 * j;
                pp[j] = (j < 2) ? (u32x4*)((bf16*)(ws + WS_QK) + (size_t)t * 1024 + v * 64 + 8 * cc)
                                : (u32x4*)((bf16*)(ws + WS_KH) + ((size_t)(b * 16 + v - 16) * SEQ + sq_) * 64 + 8 * cc);
                raw[j] = *pp[j];
            }
#pragma unroll
            for (int j = 0; j < 4; ++j) {
                u32x4* p = pp[j];
                float x[8]; unpack8(raw[j], x);
                float ss = 0.f;
#pragma unroll
                for (int e = 0; e < 8; ++e) ss += x[e] * x[e];
                ss += __shfl_xor(ss, 1); ss += __shfl_xor(ss, 2); ss += __shfl_xor(ss, 4);
                const float rinv = __builtin_amdgcn_rsqf(ss * (1.0f / 64.0f) + EPS);
                float o[8];
#pragma unroll
                for (int e = 0; e < 8; ++e) o[e] = x[e] * rinv * (j < 2 ? gqv[e] : gkv[e]);
                *p = pack8(o);
            }
        }
    }
    LAS double* sd = (LAS double*)lds;
    for (int sq = cx.bid; sq < 64; sq += cx.G) {
        const int b = sq >> 4, hd = sq & 15; const float bfv = INP(27)[hd];
        const float* F = (const float*)(ws + WS_FLOG) + ((size_t)b * SEQ + 8 * tid) * 16 + hd;
        double pre[8]; double run = 0.0;
#pragma unroll
        for (int e = 0; e < 8; ++e) { const float z = F[e * 16] + bfv; const float lf = fminf(z, 0.f) - __logf(1.0f + __expf(-fabsf(z))); run += (double)lf; pre[e] = run; }
        __syncthreads();
        sd[tid] = run; __syncthreads();
        int cur = 0;
        for (int off = 1; off < 512; off <<= 1) { double v = sd[cur * 512 + tid]; if (tid >= off) v += sd[cur * 512 + tid - off]; sd[(cur ^ 1) * 512 + tid] = v; __syncthreads(); cur ^= 1; }
        const double excl = sd[cur * 512 + tid] - run;
        u32x4* QA = (u32x4*)((bf16*)(ws + WS_QAUG) + ((size_t)sq * SEQ + 8 * tid) * 8);
        u32x4* KA = (u32x4*)((bf16*)(ws + WS_KAUG) + ((size_t)sq * SEQ + 8 * tid) * 16);
#pragma unroll
        for (int e = 0; e < 8; ++e) {
            const float c = (float)((excl + pre[e]) * (double)LOG2E);
            float c0, c1, c2; split3(c, c0, c1, c2);
            u32x4 qa; qa.x = pk2(c0, c1); qa.y = pk2(c2, 1.f); qa.z = pk2(1.f, 1.f); qa.w = 0u;
            u32x4 k0; k0.x = pk2(1.f, 1.f); k0.y = pk2(1.f, -c0); k0.z = pk2(-c1, -c2); k0.w = 0u;
            u32x4 k1; k1.x = pk2(1.f, 1.f); k1.y = pk2(1.f, 0.f); k1.z = 0u; k1.w = 0u;
            QA[e] = qa; KA[2 * e] = k0; KA[2 * e + 1] = k1;
        }
        __syncthreads();
    }
}

#define MFMA32(a, b, c) __builtin_amdgcn_mfma_f32_32x32x16_bf16((a), (b), (c), 0, 0, 0)
typedef short v4i16_t __attribute__((ext_vector_type(4)));
__device__ __forceinline__ s16x4 vtr(LAS const unsigned char* p) { return __builtin_bit_cast(s16x4, __builtin_amdgcn_ds_read_tr16_b64_v4i16((LAS v4i16_t*)p)); }

template <int DKT>
__device__ __forceinline__ void qk_tile_plain(f32x16 (&sa)[2], LAS const unsigned char* kbase, const bf16x8 (&q)[DKT / 16], int r, int h) {
    constexpr int KSTR = DKT + 8;
#pragma unroll
    for (int kb = 0; kb < 2; ++kb) {
#pragma unroll
        for (int i = 0; i < 16; ++i) sa[kb][i] = 0.f;
#pragma unroll
        for (int s = 0; s < DKT / 16; ++s) { const bf16x8 kf = *(LAS const bf16x8*)(kbase + ((32 * kb + r) * KSTR + 16 * s + 8 * h) * 2); sa[kb] = MFMA32(kf, q[s], sa[kb]); }
    }
}
__device__ __forceinline__ float max3f(float a, float b, float c) { return fmaxf(fmaxf(a, b), c); }

constexpr float ATT_THR = 8.0f;
#ifndef ATT_DEEP
#define ATT_DEEP(DK, DV) ((DK) == 64)
#endif
template <int DK, int DV, bool AUG>
__device__ __forceinline__ void attn_pass(const Ctx& cx, LAS unsigned char* lds, const bf16* __restrict__ Qg, int qp, const bf16* __restrict__ Kg, int kp, const bf16* __restrict__ Vg, int vp,
                                          const bf16* __restrict__ qaug, const bf16* __restrict__ kaug, int qb, f32x16 (&o)[DV / 32]) {
    constexpr int DKT = DK + (AUG ? 16 : 0), KSTR = DKT + 8, VSTR = DV + 32, KBY = 64 * KSTR * 2, VBY = 64 * VSTR * 2;
    constexpr int OFF_K = 0, OFF_V = 2 * KBY, ATT_BYTES = 2 * KBY + 2 * VBY;
    constexpr int KCPR = DK / 8, VCPR = DV / 8, NKC = 64 * KCPR, NVC = 64 * VCPR, NS = DKT / 16, NQK = 2 * NS;
    static_assert(ATT_BYTES <= LDS_MAIN && (DK != 64 || DV != 128 || ATT_BYTES <= 65536), "attention LDS (the differential pass parks its first map at 64 KiB)");
    const int tid = cx.tid, lane = tid & 63, r = lane & 31, h = lane >> 5, wid = __builtin_amdgcn_readfirstlane(tid >> 6);
    const int R0 = qb * 256 + wid * 32;
    const GAS bf16* Qg1 = (const GAS bf16*)Qg; const GAS bf16* Kg1 = (const GAS bf16*)Kg; const GAS bf16* Vg1 = (const GAS bf16*)Vg; const GAS bf16* qaug1 = (const GAS bf16*)qaug; const GAS bf16* kaug1 = (const GAS bf16*)kaug;
    bf16x8 q[NS];
#pragma unroll
    for (int s = 0; s < DK / 16; ++s) q[s] = *(const GAS bf16x8*)(Qg1 + (size_t)(R0 + r) * qp + 16 * s + 8 * h);
    if (AUG) { q[NS - 1] = (bf16x8){0, 0, 0, 0, 0, 0, 0, 0}; if (h == 0) q[NS - 1] = *(const GAS bf16x8*)(qaug1 + (size_t)(R0 + r) * 8); }
#pragma unroll
    for (int d = 0; d < DV / 32; ++d)
#pragma unroll
        for (int i = 0; i < 16; ++i) o[d][i] = 0.f;
    float m = AUG ? 0.f : -1e30f, lsum = 0.f;
    const int nt = 4 * (qb + 1), jmax = 4 * qb + (wid >> 1);
    const int krow0 = tid / KCPR, kcol0 = (tid - krow0 * KCPR) * 8, krow1 = (tid + 512) / KCPR, kcol1 = ((tid + 512) - krow1 * KCPR) * 8;
    const int vrow0 = tid / VCPR, vcol0 = (tid - vrow0 * VCPR) * 8, vrow1 = (tid + 512) / VCPR, vcol1 = ((tid + 512) - vrow1 * VCPR) * 8;
    const bool k1 = (NKC > 512) && (tid + 512 < NKC);
    u32x4 kr0_0, kr1_0 = {0u, 0u, 0u, 0u}, vr0_0, vr1_0 = {0u, 0u, 0u, 0u}, ka_0 = {0u, 0u, 0u, 0u};
    u32x4 kr0_1, kr1_1 = {0u, 0u, 0u, 0u}, vr0_1, vr1_1 = {0u, 0u, 0u, 0u}, ka_1 = {0u, 0u, 0u, 0u};
    const int krow1c = krow1 < 64 ? krow1 : 63, karow = (tid >> 1) & 63;
#define ATT_LOADK(j, S) do { const size_t kb_ = (size_t)(j) * 64; \
        kr0_##S = *(const GAS u32x4*)(Kg1 + (kb_ + krow0) * kp + kcol0); if (NKC > 512) kr1_##S = *(const GAS u32x4*)(Kg1 + (kb_ + krow1c) * kp + kcol1); \
        if (AUG) ka_##S = *(const GAS u32x4*)(kaug1 + (kb_ + karow) * 16 + (tid & 1) * 8); } while (0)
#define ATT_LOADV(j, S) do { const size_t kb_ = (size_t)(j) * 64; \
        vr0_##S = *(const GAS u32x4*)(Vg1 + (kb_ + vrow0) * vp + vcol0); if (NVC > 512) vr1_##S = *(const GAS u32x4*)(Vg1 + (kb_ + vrow1) * vp + vcol1); } while (0)
#define ATT_STOREK(buf, S) do { LAS unsigned char* b_ = lds + OFF_K + (buf) * KBY; \
        *(LAS u32x4*)(b_ + (krow0 * KSTR + kcol0) * 2) = kr0_##S; if (k1) *(LAS u32x4*)(b_ + (krow1 * KSTR + kcol1) * 2) = kr1_##S; \
        if (AUG && tid < 128) *(LAS u32x4*)(b_ + ((tid >> 1) * KSTR + DK + (tid & 1) * 8) * 2) = ka_##S; } while (0)
#define ATT_STOREV(buf, S) do { LAS unsigned char* b_ = lds + OFF_V + (buf) * VBY; \
        *(LAS u32x4*)(b_ + (vrow0 * VSTR + vcol0) * 2) = vr0_##S; if (NVC > 512) *(LAS u32x4*)(b_ + (vrow1 * VSTR + vcol1) * 2) = vr1_##S; } while (0)
    constexpr bool DEEP = ATT_DEEP(DK, DV);
    ATT_LOADK(0, 0); ATT_LOADV(0, 0); ATT_STOREK(0, 0); ATT_STOREV(0, 0);
    ATT_LOADK(1, 0); ATT_STOREK(1, 0);
    if (DEEP) { ATT_LOADK(2, 1); ATT_LOADV(1, 1); }
    __syncthreads();
    f32x16 sc[2], sn[2];
    qk_tile_plain<DKT>(sc, lds + OFF_K, q, r, h);
    __syncthreads();
    const int voff = (((lane & 15) >> 2) + 4 * h) * VSTR * 2 + ((lane >> 4) & 1) * 32 + (lane & 3) * 8;
    const int koff = (r * KSTR + 8 * h) * 2;
    for (int j2 = 0; j2 < nt; j2 += 2) {
#pragma unroll
      for (int half = 0; half < 2; ++half) {
        const int j = j2 + half;
        constexpr int LA = DEEP ? 1 : 0;
        if (DEEP) {
            if (half == 0) { ATT_STOREK(0, 1); ATT_STOREV(1, 1); } else { ATT_STOREK(1, 0); ATT_STOREV(0, 0); }
        }
        { const int jk = (j + 2 + LA < nt) ? j + 2 + LA : nt - 1, jv = (j + 1 + LA < nt) ? j + 1 + LA : nt - 1;
          if (half == 0) { ATT_LOADK(jk, 0); ATT_LOADV(jv, 0); } else { ATT_LOADK(jk, 1); ATT_LOADV(jv, 1); } }
        if (j <= jmax) {
            LAS const unsigned char* kn = lds + OFF_K + ((j + 1) & 1) * KBY + koff;
            LAS const unsigned char* vbase = lds + OFF_V + (j & 1) * VBY + voff;
            if (j == jmax) {
                const int qrow = R0 + r;
#pragma unroll
                for (int kb = 0; kb < 2; ++kb)
#pragma unroll
                    for (int i = 0; i < 16; ++i) { const int key = 64 * j + 32 * kb + crow(i, h); if (key > qrow) sc[kb][i] = -1e30f; }
            }
            float mx = max3f(sc[0][0], sc[0][1], sc[1][0]);
#pragma unroll
            for (int i = 2; i < 16; i += 2) mx = max3f(mx, sc[0][i], sc[0][i + 1]);
#pragma unroll
            for (int i = 1; i < 15; i += 2) mx = max3f(mx, sc[1][i], sc[1][i + 1]);
            mx = fmaxf(mx, sc[1][15]);
            mx = fmaxf(mx, __shfl_xor(mx, 32));
            if (AUG) {
                if (__builtin_amdgcn_ballot_w64(mx > ATT_THR) != 0ull) {
                    const float dlt = fmaxf(mx, 0.f), alpha = fexp2(-dlt); m += dlt; lsum *= alpha;
#pragma unroll
                    for (int d = 0; d < DV / 32; ++d)
#pragma unroll
                        for (int i = 0; i < 16; ++i) o[d][i] *= alpha;
#pragma unroll
                    for (int kb = 0; kb < 2; ++kb)
#pragma unroll
                        for (int i = 0; i < 16; ++i) sc[kb][i] -= dlt;
                    const bf16x8 mf = split3frag(-m);
                    if (h == 1) q[NS - 1] = mf;
                }
            } else if (__builtin_amdgcn_ballot_w64(mx > m + ATT_THR) != 0ull) {
                const float mn = fmaxf(m, mx), alpha = fexp2(m - mn); m = mn; lsum *= alpha;
#pragma unroll
                for (int d = 0; d < DV / 32; ++d)
#pragma unroll
                    for (int i = 0; i < 16; ++i) o[d][i] *= alpha;
            }
#pragma unroll
            for (int kb = 0; kb < 2; ++kb)
#pragma unroll
                for (int i = 0; i < 16; ++i) sn[kb][i] = 0.f;
            bf16x8 pf[2][2];
            bf16x8 kfr[10][2];
            float ps = 0.f;
#define KFRAG(t) (*(LAS const bf16x8*)(kn + ((32 * ((t) & 1)) * KSTR + 16 * ((t) >> 1)) * 2))
#define VREAD(g, d, LO, HI) do { LAS const unsigned char* vp_ = vbase + (16 * (g)) * VSTR * 2 + 64 * (d); LO = vtr(vp_); HI = vtr(vp_ + 8 * VSTR * 2); } while (0)
            s16x4 vlo[5][DV / 32], vhi[5][DV / 32];
#pragma unroll
            for (int c0 = 0; c0 < 2; ++c0)
#pragma unroll
                for (int t = c0 * NQK / 8; t < (c0 + 1) * NQK / 8; ++t) kfr[c0][t - c0 * NQK / 8] = KFRAG(t);
            __builtin_amdgcn_sched_barrier(0);
#pragma unroll
            for (int c = 0; c < 8; ++c) {
                if (c + 2 < 8) {
#pragma unroll
                    for (int t = (c + 2) * NQK / 8; t < (c + 3) * NQK / 8; ++t) kfr[c + 2][t - (c + 2) * NQK / 8] = KFRAG(t);
                } else if (c == 6) {
#pragma unroll
                    for (int d = 0; d < DV / 32; ++d) VREAD(0, d, vlo[0][d], vhi[0][d]);
                }
#pragma unroll
                for (int t = c * NQK / 8; t < (c + 1) * NQK / 8; ++t) sn[t & 1] = MFMA32(kfr[c][t - c * NQK / 8], q[t >> 1], sn[t & 1]);
                const int kbc = c >> 2, i0 = 4 * (c & 3);
#pragma unroll
                for (int e = 0; e < 4; ++e) { const float p = AUG ? fexp2(sc[kbc][i0 + e]) : fexp2(sc[kbc][i0 + e] - m); sc[kbc][i0 + e] = p; ps += p; }
                if (c & 1) {
                    const int s8 = 8 * ((c & 3) >> 1);
                    u32x4 w; w.x = pk2(sc[kbc][s8], sc[kbc][s8 + 1]); w.y = pk2(sc[kbc][s8 + 2], sc[kbc][s8 + 3]); w.z = pk2(sc[kbc][s8 + 4], sc[kbc][s8 + 5]); w.w = pk2(sc[kbc][s8 + 6], sc[kbc][s8 + 7]);
                    pf[kbc][(c & 3) >> 1] = __builtin_bit_cast(bf16x8, w);
                }
                __builtin_amdgcn_sched_barrier(0);
            }
            lsum += ps;
#pragma unroll
            for (int g = 0; g < 4; ++g) {
                if (g + 1 < 4) {
#pragma unroll
                    for (int d = 0; d < DV / 32; ++d) VREAD(g + 1, d, vlo[g + 1][d], vhi[g + 1][d]);
                }
#pragma unroll
                for (int d = 0; d < DV / 32; ++d) {
                    const bf16x8 vf = __builtin_shufflevector(vlo[g][d], vhi[g][d], 0, 1, 2, 3, 4, 5, 6, 7);
                    o[d] = MFMA32(vf, pf[g >> 1][g & 1], o[d]);
                }
                __builtin_amdgcn_sched_barrier(0);
            }
#undef KFRAG
#undef VREAD
            sc[0] = sn[0]; sc[1] = sn[1];
        }
        if (!DEEP) { if (half == 0) { ATT_STOREK(0, 0); ATT_STOREV(1, 0); } else { ATT_STOREK(1, 1); ATT_STOREV(0, 1); } }
        __syncthreads();
      }
    }
#undef ATT_LOADK
#undef ATT_LOADV
#undef ATT_STOREK
#undef ATT_STOREV
    const float l = lsum + __shfl_xor(lsum, 32), inv = __builtin_amdgcn_rcpf(l);
#pragma unroll
    for (int d = 0; d < DV / 32; ++d)
#pragma unroll
        for (int i = 0; i < 16; ++i) o[d][i] *= inv;
}

__device__ __forceinline__ bool attn_next(const Ctx& cx, int i, int NU, int NBH, int& bh, int& qb) {
    const int G = cx.G, c = cx.bid;
    if (G == 256) {
        if (i >= NBH / 16) return false;
        const int x = c & 7, ci = c >> 3, g = ci >> 4, k = ci & 15;
        bh = x + 8 * (2 * i + g); qb = (i & 1) ? k : 15 - k; return true;
    }
    const int u = i * G + ((i & 1) ? (G - 1 - c) : c);
    if (u >= NU) return false;
    qb = 15 - u / NBH; bh = u % NBH; return true;
}

__device__ __forceinline__ void attn_diff_phase(const Args& a, const Ctx& cx, LAS unsigned char* lds) {
    unsigned char* ws = cx.ws;
    const int tid = cx.tid, lane = tid & 63, r = lane & 31, h = lane >> 5, wid = tid >> 6;
    const float lambda_init = 0.2f;
    const float lam = __expf(wave_sum(INP(20)[lane] * INP(21)[lane])) - __expf(wave_sum(INP(22)[lane] * INP(23)[lane])) + lambda_init;
    const float* subg = INP(24);
    int bh, qb;
    for (int it = 0; attn_next(cx, it, 512, 32, bh, qb); ++it) {
        const int b = bh >> 3, hd = bh & 7;
        const bf16* Q = (const bf16*)(ws + WS_QK) + (size_t)b * SEQ * 2048 + hd * 128;
        const bf16* K = Q + 1024;
        const bf16* V = (const bf16*)(ws + WS_VA) + (size_t)b * SEQ * 1024 + hd * 128;
        f32x16 o1[4];
        attn_pass<64, 128, false>(cx, lds, Q, 2048, K, 2048, V, 1024, nullptr, nullptr, qb, o1);
        LAS unsigned* park = (LAS unsigned*)(lds + 65536 + wid * 8192) + lane;
#pragma unroll
        for (int d = 0; d < 4; ++d)
#pragma unroll
            for (int i = 0; i < 8; ++i) park[(d * 8 + i) * 64] = pk2(o1[d][2 * i], o1[d][2 * i + 1]);
        attn_pass<64, 128, false>(cx, lds, Q + 64, 2048, K + 64, 2048, V, 1024, nullptr, nullptr, qb, o1);
        float ss = 0.f;
#pragma unroll
        for (int d = 0; d < 4; ++d)
#pragma unroll
            for (int i = 0; i < 8; ++i) {
                const unsigned pw = park[(d * 8 + i) * 64];
                const float a0 = __uint_as_float(pw << 16), a1 = __uint_as_float(pw & 0xffff0000u);
                const float v0 = a0 - lam * o1[d][2 * i], v1 = a1 - lam * o1[d][2 * i + 1];
                o1[d][2 * i] = v0; o1[d][2 * i + 1] = v1; ss += v0 * v0 + v1 * v1;
            }
        ss += __shfl_xor(ss, 32);
        const float rinv = (1.0f - lambda_init) * __builtin_amdgcn_rsqf(ss * (1.0f / 128.0f) + EPS);
        bf16* O = (bf16*)(ws + WS_A) + ((size_t)b * SEQ + qb * 256 + wid * 32 + r) * 2048 + hd * 128;
#pragma unroll
        for (int d = 0; d < 4; ++d)
#pragma unroll
            for (int g = 0; g < 4; ++g) {
                const int dv = 32 * d + 8 * g + 4 * h; const f32x4 sg = *(const f32x4*)(subg + dv);
                u32x2 w; w.x = pk2(o1[d][4 * g] * rinv * sg.x, o1[d][4 * g + 1] * rinv * sg.y); w.y = pk2(o1[d][4 * g + 2] * rinv * sg.z, o1[d][4 * g + 3] * rinv * sg.w);
                *(u32x2*)(O + dv) = w;
            }
    }
}

__device__ __forceinline__ void attn_mla_phase(const Args& a, const Ctx& cx, LAS unsigned char* lds) {
    unsigned char* ws = cx.ws;
    const int tid = cx.tid, lane = tid & 63, r = lane & 31, h = lane >> 5, wid = tid >> 6;
    int bh, qb;
    for (int it = 0; attn_next(cx, it, 512, 32, bh, qb); ++it) {
        const int b = bh >> 3, hd = bh & 7;
        const bf16* Q = (const bf16*)(ws + WS_QB) + (size_t)b * SEQ * 768 + hd * 96;
        const bf16* K = (const bf16*)(ws + WS_KB) + (size_t)b * SEQ * 768 + hd * 96;
        const bf16* V = (const bf16*)(ws + WS_KVB) + (size_t)b * SEQ * 1536 + hd * 192 + 64;
        f32x16 o[4];
        attn_pass<96, 128, false>(cx, lds, Q, 768, K, 768, V, 1536, nullptr, nullptr, qb, o);
        bf16* O = (bf16*)(ws + WS_A) + ((size_t)b * SEQ + qb * 256 + wid * 32 + r) * 2048 + 1024 + hd * 128;
#pragma unroll
        for (int d = 0; d < 4; ++d)
#pragma unroll
            for (int g = 0; g < 4; ++g) { u32x2 w; w.x = pk2(o[d][4 * g], o[d][4 * g + 1]); w.y = pk2(o[d][4 * g + 2], o[d][4 * g + 3]); *(u32x2*)(O + 32 * d + 8 * g + 4 * h) = w; }
    }
}

__device__ __forceinline__ void attn_fox_phase(const Args& a, const Ctx& cx, LAS unsigned char* lds) {
    unsigned char* ws = cx.ws;
    const int tid = cx.tid, lane = tid & 63, r = lane & 31, h = lane >> 5, wid = tid >> 6;
    int bh, qb;
    for (int it = 0; attn_next(cx, it, 1024, 64, bh, qb); ++it) {
        const int b = bh >> 4, hd = bh & 15;
        const bf16* Q = (const bf16*)(ws + WS_QK) + (size_t)b * SEQ * 1024 + hd * 64;
        const bf16* K = (const bf16*)(ws + WS_KH) + (size_t)bh * SEQ * 64;
        const bf16* V = (const bf16*)(ws + WS_VA) + (size_t)bh * SEQ * 64;
        f32x16 o[2];
        attn_pass<64, 64, true>(cx, lds, Q, 1024, K, 64, V, 64, (const bf16*)(ws + WS_QAUG) + (size_t)bh * SEQ * 8, (const bf16*)(ws + WS_KAUG) + (size_t)bh * SEQ * 16, qb, o);
        const size_t ro = ((size_t)b * SEQ + qb * 256 + wid * 32 + r) * 1024 + hd * 64;
        bf16* O = (bf16*)(ws + WS_A) + ro; const bf16* OG = (const bf16*)(ws + WS_OG) + ro;
        u32x2 gvv[2][4];
#pragma unroll
        for (int d = 0; d < 2; ++d)
#pragma unroll
            for (int g = 0; g < 4; ++g) gvv[d][g] = *(const u32x2*)(OG + 32 * d + 8 * g + 4 * h);
#pragma unroll
        for (int d = 0; d < 2; ++d)
#pragma unroll
            for (int g = 0; g < 4; ++g) {
                const int dv = 32 * d + 8 * g + 4 * h; const u32x2 gv = gvv[d][g];
                const float g0 = __uint_as_float(gv.x << 16), g1 = __uint_as_float(gv.x & 0xffff0000u), g2 = __uint_as_float(gv.y << 16), g3 = __uint_as_float(gv.y & 0xffff0000u);
                u32x2 w; w.x = pk2(o[d][4 * g] * sigmoidf_(g0), o[d][4 * g + 1] * sigmoidf_(g1)); w.y = pk2(o[d][4 * g + 2] * sigmoidf_(g2), o[d][4 * g + 3] * sigmoidf_(g3));
                *(u32x2*)(O + dv) = w;
            }
    }
}

#define XB_TMO      128
#define XB_XCNT(j)  (256  + 64 * (j))
#define XB_XSUB(j)  (1280 + 64 * (j))
#define XB_XGEN(j)  (2304 + 64 * (j))
#define XB_TOP      3328
#define XB_TOPGEN   3392
#define XCD_BAR_WORDS 3456
#define XB_SPIN_CAP (1u << 18)

__device__ __forceinline__ unsigned xb_ld(unsigned* p)              { return __hip_atomic_load(p, __ATOMIC_RELAXED, __HIP_MEMORY_SCOPE_AGENT); }
__device__ __forceinline__ unsigned xb_add(unsigned* p, unsigned v) { return __hip_atomic_fetch_add(p, v, __ATOMIC_RELAXED, __HIP_MEMORY_SCOPE_AGENT); }
__device__ __forceinline__ unsigned xb_xcc_id() { return (unsigned)__builtin_amdgcn_s_getreg((3 << 11) | 20) & 0xFu; }
#define XB_SPIN(cond, bar) do { unsigned _sp = 0; while (cond) { __builtin_amdgcn_s_sleep(1); \
    if ((++_sp & 255u) == 0u) { if (xb_ld(&(bar)[XB_TMO])) break; if (_sp > XB_SPIN_CAP) { atomicAdd(&(bar)[XB_TMO], 1u); break; } } } } while (0)

struct XcdBarrier {
    unsigned* bar; unsigned x;
    volatile LAS unsigned* st;
};

__device__ __forceinline__ XcdBarrier xcd_barrier_post(unsigned* bar, volatile LAS unsigned* st) {
    XcdBarrier b; b.bar = bar; b.x = xb_xcc_id(); b.st = st;
    if (threadIdx.x == 0) (void)xb_add(&bar[XB_XCNT(b.x)], 1u);
    return b;
}
__device__ __forceinline__ void xcd_barrier_complete(unsigned* bar, unsigned x, unsigned& nloc, unsigned& nx) {
    const unsigned G = gridDim.x * gridDim.y * gridDim.z;
    unsigned sum, cnt, mine, sp = 0u;
    for (;;) {
        sum = 0u; cnt = 0u; mine = 0u;
#pragma unroll
        for (unsigned j = 0; j < 16; ++j) { const unsigned c = xb_ld(&bar[XB_XCNT(j)]); sum += c; cnt += (c > 0u) ? 1u : 0u; mine = (j == x) ? c : mine; }
        if (sum == G) break;
        __builtin_amdgcn_s_sleep(1);
        if ((++sp & 255u) == 0u) { if (xb_ld(&bar[XB_TMO])) break; if (sp > XB_SPIN_CAP) { atomicAdd(&bar[XB_TMO], 1u); break; } }
    }
    nloc = mine > 0u ? mine : 1u; nx = cnt > 0u ? cnt : 1u;
}

__device__ __forceinline__ void xcd_barrier(const XcdBarrier& b) {
    asm volatile("s_waitcnt vmcnt(0)" ::: "memory");
    __syncthreads();
    if (threadIdx.x == 0) {
        unsigned* bar = b.bar;
        __builtin_amdgcn_s_waitcnt(0);
        unsigned nloc = b.st[0], nx = b.st[1];
        if (nloc == 0u) { xcd_barrier_complete(bar, b.x, nloc, nx); b.st[0] = nloc; b.st[1] = nx; }
        const unsigned old = xb_add(&bar[XB_XSUB(b.x)], 1u);
        const unsigned gen = old / nloc;
        if (old + 1u == (gen + 1u) * nloc) {
            __builtin_amdgcn_fence(__ATOMIC_RELEASE, "agent");
            asm volatile("s_waitcnt vmcnt(0)" ::: "memory");
            const unsigned og = xb_add(&bar[XB_TOP], 1u);
            const unsigned tg = og / nx;
            if (og + 1u == (tg + 1u) * nx) xb_add(&bar[XB_TOPGEN], 1u);
            else XB_SPIN(xb_ld(&bar[XB_TOPGEN]) == tg, bar);
            __builtin_amdgcn_fence(__ATOMIC_ACQUIRE, "agent");
            xb_add(&bar[XB_XGEN(b.x)], 1u);
            asm volatile("s_waitcnt vmcnt(0)" ::: "memory");
        } else {
            XB_SPIN(xb_ld(&bar[XB_XGEN(b.x)]) == gen, bar);
            __builtin_amdgcn_fence(__ATOMIC_ACQUIRE, "agent");
            asm volatile("s_waitcnt vmcnt(0)" ::: "memory");
        }
    }
    __syncthreads();
}

enum { PH_PROLOGUE = 0, PH_MOD0, PH_GU, PH_DOWN, PH_IN, PH_PREP1E, PH_ATT_DIFF, PH_GEMM_MLA, PH_PREP2E, PH_ATT_MLA, PH_OUT, PH_PREPO, PH_ATT_FOX };
constexpr int NPHASES = 21;
__constant__ const unsigned char PH_TYPE[NPHASES] = {PH_PROLOGUE, PH_MOD0,
    PH_GU, PH_DOWN, PH_IN, PH_PREP1E, PH_ATT_DIFF, PH_GEMM_MLA, PH_PREP2E, PH_ATT_MLA, PH_OUT, PH_GU, PH_DOWN,
    PH_GU, PH_DOWN, PH_IN, PH_PREPO, PH_ATT_FOX, PH_OUT, PH_GU, PH_DOWN};
__constant__ const unsigned char PH_LAYER[NPHASES] = {0, 0, 0, 0, 0, 0, 0, 0, 0, 0, 0, 0, 0, 1, 1, 1, 1, 1, 1, 1, 1};
__constant__ const unsigned char PH_SUB[NPHASES] = {0, 0, 0, 0, 0, 0, 0, 0, 0, 0, 0, 1, 1, 0, 0, 0, 0, 0, 0, 1, 1};

__global__ void __launch_bounds__(NTHR, 2) mk_fwd(Args a) {
    extern __shared__ __attribute__((aligned(16))) unsigned char lds_raw[];
    LAS unsigned char* lds = (LAS unsigned char*)lds_raw;
    cg::grid_group grid = cg::this_grid();
    if (a.ph_lo < 0) grid.sync();
    volatile LAS unsigned* bst = (volatile LAS unsigned*)(lds + LDS_MAIN);
    if (threadIdx.x < 16) bst[threadIdx.x] = 0u;
    __syncthreads();
    const XcdBarrier bar = xcd_barrier_post((unsigned*)(a.ws + WS_CTL), bst);
    const int G = gridDim.x;
    for (int ph = a.ph_lo; ph < a.ph_hi; ++ph) {
        Ctx cx;
        { int zi; asm volatile("s_mov_b32 %0, 0" : "=s"(zi)); cx.zi = zi; }
        { int t_ = threadIdx.x; asm volatile("" : "+v"(t_)); cx.tid = t_; }
        { int b_ = blockIdx.x; asm volatile("" : "+s"(b_)); cx.bid = b_; }
        { int g_ = gridDim.x; asm volatile("" : "+s"(g_)); cx.G = g_; }
        unsigned char* ws = a.ws; asm volatile("" : "+s"(ws)); cx.ws = ws;
        const int G = cx.G;
        float* xbuf = a.out; asm volatile("" : "+s"(xbuf));
        const int type = PH_TYPE[ph], l = PH_LAYER[ph], sub = PH_SUB[ph];
        const float* modl = (const float*)(ws + WS_MOD) + (size_t)l * 4 * NMOD;
        if (type == PH_PROLOGUE) prologue_phase(a, cx, lds);
        else if (type == PH_MOD0) mod0_phase(a, cx);
        else if (type == PH_GU) {
            pg8::Gemm g{(const pg8::bf16_t*)(ws + (sub == 0 ? WS_A : WS_C)), (const pg8::bf16_t*)(ws + WS_WGU) + (size_t)(l * 2 + sub) * 5632 * 1024, T, 2 * FF, DM};
            pg8::StaticOrder S; S.init(T, 2 * FF, G, cx.bid);
            EpiSwiglu E{(bf16*)(ws + WS_ACT), FF, (const float*)(ws + WS_SSQ), (const float*)(ws + WS_BIASV) + (size_t)(l * 2 + sub) * 4 * 5632};
            pg8::gemm_phase<EpiSwiglu, pg8::StaticOrder, PG8_ALIGN, PG8_SP2>(lds, g, S, E, cx.tid);
        } else if (type == PH_DOWN || type == PH_OUT) {
            const bool isdown = type == PH_DOWN;
            const pg8::bf16_t* Ap = (const pg8::bf16_t*)(ws + (isdown ? WS_ACT : WS_A));
            const pg8::bf16_t* Bp = isdown ? (const pg8::bf16_t*)(ws + WS_WD) + (size_t)(l * 2 + sub) * 1024 * 2816 : (const pg8::bf16_t*)(ws + (l == 0 ? WS_WOUT_E : WS_WOUT_O));
            const int Kd = isdown ? FF : (l == 0 ? 2048 : 1024);
            const pg8::Gemm g{Ap, Bp, T, DM, Kd};
            const EpiResid E{ws, INP(0), xbuf, (isdown ? 1 : 0) | (sub << 1) | (l << 2)};
            pg8::StaticOrder S; S.init(T, DM, G, cx.bid);
            pg8::gemm_phase<EpiResid, pg8::StaticOrder, false, PG8_SP2>(lds, g, S, E, cx.tid);
        } else if (type == PH_IN || type == PH_GEMM_MLA) {
            const int nsub = (type == PH_GEMM_MLA) ? 2 : 1;
            for (int si = 0; si < nsub; ++si) {
                pg8::Gemm g; EpiStore E;
                if (type == PH_IN && l == 0) {
                    g = pg8::Gemm{(const pg8::bf16_t*)(ws + WS_A), (const pg8::bf16_t*)(ws + WS_WIN_E), T, 3840, DM};
                    E = EpiStore{(bf16*)(ws + WS_QK), (bf16*)(ws + WS_VA), (bf16*)(ws + WS_LAT), (bf16*)(ws + WS_LAT), 2048, 1024, 768, 768, 8, 12, 1000, -1, nullptr, (const float*)(ws + WS_SSQ), (const float*)(ws + WS_BIASV) + BV_IN_E, 3840, 0};
                } else if (type == PH_IN) {
                    g = pg8::Gemm{(const pg8::bf16_t*)(ws + WS_A), (const pg8::bf16_t*)(ws + WS_WIN_O), T, 4352, DM};
                    E = EpiStore{(bf16*)(ws + WS_QK), (bf16*)(ws + WS_KH), (bf16*)(ws + WS_VA), (bf16*)(ws + WS_OG), 1024, 1024, 1024, 1024, 4, 8, 12, 16, (float*)(ws + WS_FLOG), (const float*)(ws + WS_SSQ), (const float*)(ws + WS_BIASV) + BV_IN_O, 4352, (64 << 8) | (64 << 16)};
                } else if (si == 0) {
                    g = pg8::Gemm{(const pg8::bf16_t*)(ws + WS_CQN), (const pg8::bf16_t*)(ws + WS_WQB), T, 768, 384};
                    E = EpiStore{(bf16*)(ws + WS_QB), (bf16*)(ws + WS_QB), (bf16*)(ws + WS_QB), (bf16*)(ws + WS_QB), 768, 768, 768, 768, 1000, 1000, 1000, -1, nullptr, nullptr, (const float*)(ws + WS_BIASV), 0, 0};
                } else {
                    g = pg8::Gemm{(const pg8::bf16_t*)(ws + WS_CKVN), (const pg8::bf16_t*)(ws + WS_WKVB), T, 1536, 256};
                    E = EpiStore{(bf16*)(ws + WS_KVB), (bf16*)(ws + WS_KVB), (bf16*)(ws + WS_KVB), (bf16*)(ws + WS_KVB), 1536, 1536, 1536, 1536, 1000, 1000, 1000, -1, nullptr, nullptr, (const float*)(ws + WS_BIASV), 0, 0};
                }
                pg8::StaticOrder S; S.init(T, g.N, G, cx.bid);
                pg8::gemm_phase<EpiStore, pg8::StaticOrder, PG8_ALIGN, PG8_SP2>(lds, g, S, E, cx.tid);
                __syncthreads();
            }
        } else if (type == PH_PREP1E) prep1e_phase(a, cx);
        else if (type == PH_PREP2E) prep2e_phase(a, cx);
        else if (type == PH_PREPO) prepo_phase(a, cx, lds);
        else if (type == PH_ATT_DIFF) attn_diff_phase(a, cx, lds);
        else if (type == PH_ATT_MLA) attn_mla_phase(a, cx, lds);
        else if (type == PH_ATT_FOX) attn_fox_phase(a, cx, lds);
        if (ph + 1 < a.ph_hi) xcd_barrier(bar);
    }
}

extern "C" void kernel_launch(void* const* d_in, const int* in_sizes, int n_in, void* d_out, int out_size, void* d_ws, size_t ws_size, hipStream_t stream) {
    static int grid = 0;
    if (grid == 0) {
        if (n_in != 31 || out_size != T * DM || ws_size < WS_END) { fprintf(stderr, "kernel_launch: unexpected problem: n_in %d out %d ws %zu (need %zu)\n", n_in, out_size, ws_size, (size_t)WS_END); grid = -1; return; }
        int dev = 0, cus = 0, per_cu = 0;
        (void)hipGetDevice(&dev);
        (void)hipDeviceGetAttribute(&cus, hipDeviceAttributeMultiprocessorCount, dev);
        if (hipFuncSetAttribute((const void*)mk_fwd, hipFuncAttributeMaxDynamicSharedMemorySize, LDS_BYTES) != hipSuccess) fprintf(stderr, "kernel_launch: hipFuncSetAttribute failed\n");
        if (hipOccupancyMaxActiveBlocksPerMultiprocessor(&per_cu, (const void*)mk_fwd, NTHR, LDS_BYTES) != hipSuccess || per_cu < 1) { fprintf(stderr, "kernel_launch: occupancy query says %d\n", per_cu); per_cu = 1; }
        (void)hipGetLastError();
        if (cus <= 0) cus = 256;
        grid = cus * (per_cu > 1 ? 1 : per_cu);
    }
    if (grid < 0) return;
    Args a{};
    for (int i = 0; i < 31; ++i) a.in[i] = (const float*)d_in[i];
    a.out = (float*)d_out; a.ws = (unsigned char*)d_ws;
    if (hipMemsetAsync((char*)d_ws + WS_CTL, 0, CTL_ZERO_BYTES, stream) != hipSuccess) { fprintf(stderr, "kernel_launch: hipMemsetAsync failed\n"); return; }
    a.ph_lo = 0; a.ph_hi = NPHASES;
    void* args[] = {&a};
    hipError_t e = hipLaunchCooperativeKernel((const void*)mk_fwd, dim3(grid), dim3(NTHR), args, LDS_BYTES, stream);
    if (e != hipSuccess) fprintf(stderr, "kernel_launch: cooperative launch failed: %s (grid %d)\n", hipGetErrorString(e), grid);
}
```

```cpp
#include <hip/hip_runtime.h>
#include <hip/hip_cooperative_groups.h>
#include <cstdio>
#include <cstdint>
namespace cg = cooperative_groups;
namespace pg8 {
#define PG8_LAS __attribute__((address_space(3)))
typedef unsigned short bf16_t;
typedef short bf16x8 __attribute__((ext_vector_type(8)));
typedef float f32x4 __attribute__((ext_vector_type(4)));
typedef unsigned u32x4 __attribute__((ext_vector_type(4)));
constexpr int BM = 256, BK = 64, HALF = 128, HTB = HALF * BK * 2  , STAGE_BYTES = 8 * HTB, NXCD = 8, WGM = 8;

__host__ __device__ __forceinline__ int lds_byte(int r, int c) { const int st = (r >> 4) * 2 + (c >> 5), rr = r & 15, cc = c & 31, ob = rr * 64 + cc * 2; return st * 1024 + (ob ^ (((ob >> 9) & 1) << 5)); }
__host__ __device__ __forceinline__ void stage_rc(int b, int& R, int& C) { const int st = b / 1024, sb = b % 1024, swz = sb ^ (((sb >> 9) & 1) << 5); R = (st >> 1) * 16 + swz / 64; C = (st & 1) * 32 + (swz % 64) / 2; }
__host__ __device__ __forceinline__ int perm32(int rho) { const int n = rho >> 4, i = rho & 15; return 8 * (i >> 2) + 4 * n + (i & 3); }

struct Unit { int pm, pn; };
struct Gemm { const bf16_t* A; const bf16_t* Bt; int M, N, K; };

struct StaticOrder {
    int nM, nN, nwg, G, c;
    __host__ __device__ void init(int M, int N, int G_, int c_) { nM = M / BM; nN = N / BM; nwg = nM * nN; G = G_; c = c_; }
    __host__ __device__ bool next(int i, Unit& u) const {
        const long L = (long)i * G + c; if (L >= nwg) return false;
        int wgid = (int)L; { const int q = nwg / NXCD, r = nwg % NXCD, xcd = wgid % NXCD, off = wgid / NXCD; wgid = (xcd < r ? xcd * (q + 1) : r * (q + 1) + (xcd - r) * q) + off; }
        const int nig = WGM * nN, gid = wgid / nig, fm = gid * WGM, gsz = (nM - fm) < WGM ? (nM - fm) : WGM;
        u.pm = fm + ((wgid % nig) % gsz); u.pn = (wgid % nig) / gsz; return true;
    }
    __device__ __forceinline__ void a_ready(const Unit&) const {}
    __device__ __forceinline__ void done(const Unit&) const {}
};

__device__ __forceinline__ unsigned cvt_pk_bf16(float lo, float hi) { unsigned r; asm volatile("v_cvt_pk_bf16_f32 %0, %1, %2" : "=v"(r) : "v"(lo), "v"(hi)); return r; }
typedef float f32x2 __attribute__((ext_vector_type(2)));
template <class Epi, class Sched, bool ALIGN_EPI = false, bool SP2 = false>
__device__ __forceinline__ void gemm_phase(PG8_LAS unsigned char* lds, const Gemm g, const Sched& S, const Epi& E, const int tid_in) {
    const int tid = tid_in, wid = __builtin_amdgcn_readfirstlane(tid >> 6), lane = tid & 63, wr = wid >> 2, wc = wid & 3, fr = lane & 15, fq = lane >> 4;
    const int K = g.K, nt = K / BK;
    unsigned voffA[2], voffB[2];
#pragma unroll
    for (int i = 0; i < 2; ++i) { int R, C; stage_rc(tid * 16 + i * 8192, R, C); const int Rb = Epi::PERM ? ((R & ~31) + perm32(R & 31)) : R;
        voffA[i] = (unsigned)(R * K + C) * 2u; voffB[i] = (unsigned)(Rb * K + C) * 2u; }
    const size_t kstep = (size_t)(BK * 2);
    const size_t hstep = (size_t)HALF * K * 2;
    const size_t tstep = 2 * hstep;
    const unsigned ldsw = (unsigned)wid * 1024u;
    const int aoff = lds_byte(wr * 64 + fr, fq * 8), boff = lds_byte(wc * 32 + fr, fq * 8);
#define PG8_SA(b, h) (((b) * 2 + (h)) * HTB)
#define PG8_SB(b, h) ((4 + (b) * 2 + (h)) * HTB)
#define PG8_STAGE(bufoff, gbase, voff) do { _Pragma("unroll") for (int _i = 0; _i < 2; ++_i) \
        __builtin_amdgcn_global_load_lds((const unsigned*)((const char*)(gbase) + (voff)[_i]), (PG8_LAS unsigned*)(lds + (bufoff) + ldsw + _i * 8192), 16, 0, 0); } while (0)
#define PG8_LDA(dst, b, h) do { _Pragma("unroll") for (int m = 0; m < 4; ++m) _Pragma("unroll") for (int k = 0; k < 2; ++k) dst[m][k] = *(const PG8_LAS bf16x8*)(lds + PG8_SA(b, h) + aoff + m * 2048 + k * 1024); } while (0)
#define PG8_LDB(dst, b, h) do { _Pragma("unroll") for (int n = 0; n < 2; ++n) _Pragma("unroll") for (int k = 0; k < 2; ++k) dst[n][k] = *(const PG8_LAS bf16x8*)(lds + PG8_SB(b, h) + boff + n * 2048 + k * 1024); } while (0)
#define PG8_MMA(ai, bj, At, Bt) do { __builtin_amdgcn_s_setprio(1); _Pragma("unroll") for (int m = 0; m < 4; ++m) _Pragma("unroll") for (int n = 0; n < 2; ++n) _Pragma("unroll") for (int k = 0; k < 2; ++k) \
        acc[ai][bj][m][n] = __builtin_amdgcn_mfma_f32_16x16x32_bf16(Bt[n][k], At[m][k], acc[ai][bj][m][n], 0, 0, 0); __builtin_amdgcn_s_setprio(0); } while (0)
#define PG8_WAIT_V(n) asm volatile("s_waitcnt vmcnt(" #n ")" ::: "memory")
#define PG8_WAIT_L(n) asm volatile("s_waitcnt lgkmcnt(" #n ")" ::: "memory")
#define PG8_BAR __builtin_amdgcn_s_barrier()
#define PG8_SCHED __builtin_amdgcn_sched_barrier(0)
    Unit cur, nxt; int ui = 0;
    if (!S.next(0, cur)) return;
    f32x4 acc[2][2][4][2];
#pragma unroll
    for (int a = 0; a < 2; ++a)
#pragma unroll
        for (int b = 0; b < 2; ++b)
#pragma unroll
            for (int m = 0; m < 4; ++m)
#pragma unroll
                for (int n = 0; n < 2; ++n) acc[a][b][m][n] = (f32x4){0.f, 0.f, 0.f, 0.f};
    bf16x8 At[4][2], B0[2][2], B1[2][2];
    const char* cA = (const char*)g.A + (size_t)cur.pm * tstep; const char* cB = (const char*)g.Bt + (size_t)cur.pn * tstep;
    S.a_ready(cur);
    if constexpr (SP2) {
        PG8_STAGE(PG8_SB(0, 0), cB, voffB); PG8_STAGE(PG8_SB(0, 1), cB + hstep, voffB); PG8_STAGE(PG8_SA(0, 0), cA, voffA); PG8_STAGE(PG8_SA(0, 1), cA + hstep, voffA);
        if (wr == 1) PG8_BAR;
        PG8_WAIT_V(2); PG8_BAR;
        PG8_STAGE(PG8_SB(1, 0), cB + kstep, voffB); PG8_STAGE(PG8_SA(1, 0), cA + kstep, voffA); PG8_STAGE(PG8_SB(1, 1), cB + hstep + kstep, voffB);
        PG8_WAIT_V(6); PG8_BAR;
    } else {
        PG8_STAGE(PG8_SB(0, 0), cB, voffB); PG8_STAGE(PG8_SA(0, 0), cA, voffA); PG8_STAGE(PG8_SB(0, 1), cB + hstep, voffB); PG8_STAGE(PG8_SA(0, 1), cA + hstep, voffA);
        if (wr == 1) PG8_BAR;
        PG8_WAIT_V(4); PG8_BAR;
        PG8_STAGE(PG8_SB(1, 0), cB + kstep, voffB); PG8_STAGE(PG8_SA(1, 0), cA + kstep, voffA); PG8_STAGE(PG8_SB(1, 1), cB + hstep + kstep, voffB);
        PG8_WAIT_V(6); PG8_BAR;
    }
    for (;;) {
        const bool has_next = S.next(ui + 1, nxt);
        const char* nA = has_next ? (const char*)g.A + (size_t)nxt.pm * tstep : cA; const char* nB = has_next ? (const char*)g.Bt + (size_t)nxt.pn * tstep : cB;
        for (int t = 0; t < nt; t += 2) {
            const bool last = (t == nt - 2);
            const char* a1 = cA + (size_t)(t + 1) * kstep;
            const char* a2 = last ? nA : cA + (size_t)(t + 2) * kstep; const char* b2 = last ? nB : cB + (size_t)(t + 2) * kstep;
            const char* a3 = a2 + kstep; const char* b3 = b2 + kstep;
            if (last && has_next) S.a_ready(nxt);
            if constexpr (SP2) {
            PG8_LDB(B0, 0, 0); PG8_LDB(B1, 0, 1); PG8_SCHED; PG8_LDA(At, 0, 0); PG8_STAGE(PG8_SA(1, 1), a1 + hstep, voffA);
            PG8_WAIT_V(8); PG8_WAIT_L(0); PG8_BAR; PG8_MMA(0, 0, At, B0); PG8_MMA(0, 1, At, B1); PG8_BAR; PG8_SCHED;
            PG8_LDA(At, 0, 1); PG8_STAGE(PG8_SB(0, 0), b2, voffB); PG8_STAGE(PG8_SB(0, 1), b2 + hstep, voffB); PG8_STAGE(PG8_SA(0, 0), a2, voffA);
            PG8_WAIT_V(8); PG8_WAIT_L(0); PG8_BAR; PG8_MMA(1, 0, At, B0); PG8_MMA(1, 1, At, B1); PG8_BAR; PG8_SCHED;
            PG8_LDB(B0, 1, 0); PG8_LDB(B1, 1, 1); PG8_SCHED; PG8_LDA(At, 1, 0); PG8_STAGE(PG8_SA(0, 1), a2 + hstep, voffA);
            PG8_WAIT_V(8); PG8_WAIT_L(0); PG8_BAR; PG8_MMA(0, 0, At, B0); PG8_MMA(0, 1, At, B1); PG8_BAR; PG8_SCHED;
            PG8_LDA(At, 1, 1); PG8_STAGE(PG8_SB(1, 0), b3, voffB); PG8_STAGE(PG8_SB(1, 1), b3 + hstep, voffB); PG8_STAGE(PG8_SA(1, 0), a3, voffA);
            PG8_WAIT_V(8); PG8_WAIT_L(0); PG8_BAR; PG8_MMA(1, 0, At, B0); PG8_MMA(1, 1, At, B1); PG8_BAR; PG8_SCHED;
            } else {
            PG8_LDB(B0, 0, 0); PG8_SCHED; PG8_LDA(At, 0, 0); PG8_STAGE(PG8_SA(1, 1), a1 + hstep, voffA);
            PG8_WAIT_L(8); PG8_BAR; PG8_WAIT_L(0); PG8_MMA(0, 0, At, B0); PG8_BAR; PG8_SCHED;
            PG8_LDB(B1, 0, 1); PG8_STAGE(PG8_SB(0, 0), b2, voffB);
            PG8_BAR; PG8_WAIT_L(0); PG8_MMA(0, 1, At, B1); PG8_BAR;
            PG8_LDA(At, 0, 1); PG8_STAGE(PG8_SA(0, 0), a2, voffA);
            PG8_BAR; PG8_WAIT_L(0); PG8_MMA(1, 0, At, B0); PG8_BAR; PG8_SCHED;
            PG8_STAGE(PG8_SB(0, 1), b2 + hstep, voffB);
            PG8_WAIT_V(6); PG8_BAR; PG8_MMA(1, 1, At, B1); PG8_BAR;
            PG8_LDB(B0, 1, 0); PG8_SCHED; PG8_LDA(At, 1, 0); PG8_STAGE(PG8_SA(0, 1), a2 + hstep, voffA);
            PG8_WAIT_L(8); PG8_BAR; PG8_WAIT_L(0); PG8_MMA(0, 0, At, B0); PG8_BAR; PG8_SCHED;
            PG8_LDB(B1, 1, 1); PG8_STAGE(PG8_SB(1, 0), b3, voffB);
            PG8_BAR; PG8_WAIT_L(0); PG8_MMA(0, 1, At, B1); PG8_BAR;
            PG8_LDA(At, 1, 1); PG8_STAGE(PG8_SA(1, 0), a3, voffA);
            PG8_BAR; PG8_WAIT_L(0); PG8_MMA(1, 0, At, B0); PG8_BAR; PG8_SCHED;
            PG8_STAGE(PG8_SB(1, 1), b3 + hstep, voffB);
            PG8_WAIT_V(6); PG8_BAR; PG8_MMA(1, 1, At, B1); PG8_BAR;
            }
        }
        if constexpr (ALIGN_EPI) { if (wr == 0) PG8_BAR; }
        if constexpr (!Epi::AFTER_DRAIN) { E(acc, cur, wr, wc, fr, fq); S.done(cur); }
        if (!has_next) break;
#pragma unroll
        for (int a = 0; a < 2; ++a)
#pragma unroll
            for (int b = 0; b < 2; ++b)
#pragma unroll
                for (int m = 0; m < 4; ++m)
#pragma unroll
                    for (int n = 0; n < 2; ++n) acc[a][b][m][n] = (f32x4){0.f, 0.f, 0.f, 0.f};
        cur = nxt; cA = nA; cB = nB; ++ui;
        if constexpr (ALIGN_EPI) { if (wr == 1) PG8_BAR; }
    }
    PG8_WAIT_V(0);
    if constexpr (!ALIGN_EPI) { if (wr == 0) PG8_BAR; }
    PG8_BAR;
    if constexpr (Epi::AFTER_DRAIN) { E.fused(acc, cur, wr, wc, fr, fq, lds, wid, lane); S.done(cur); }
#undef PG8_SA
#undef PG8_SB
#undef PG8_STAGE
#undef PG8_LDA
#undef PG8_LDB
#undef PG8_MMA
#undef PG8_WAIT_V
#undef PG8_WAIT_L
#undef PG8_BAR
#undef PG8_SCHED
}
}
#ifndef PG8_SP2
#define PG8_SP2 true
#endif
#ifndef PG8_ALIGN
#define PG8_ALIGN true
#endif
constexpr int NB = 4, SEQ = 4096, T = NB * SEQ, DM = 1024, FF = 2816, NMOD = 9 * DM;
constexpr float EPS = 1e-6f;
constexpr float LOG2E = 1.4426950408889634f;
constexpr int NWAVES = 8, NTHR = 512;
constexpr int LDS_MAIN = 131072;
constexpr int LDS_BYTES = LDS_MAIN + 64;

#define LAS __attribute__((address_space(3)))
#define GAS __attribute__((address_space(1)))
typedef unsigned short bf16;
typedef short bf16x8 __attribute__((ext_vector_type(8)));
typedef short s16x4 __attribute__((ext_vector_type(4)));
typedef float f32x2 __attribute__((ext_vector_type(2)));
typedef float f32x4 __attribute__((ext_vector_type(4)));
typedef float f32x16 __attribute__((ext_vector_type(16)));
typedef unsigned u32x2 __attribute__((ext_vector_type(2)));
typedef unsigned u32x4 __attribute__((ext_vector_type(4)));
typedef __bf16 bf16x2_t __attribute__((ext_vector_type(2)));

constexpr size_t MiB = 1u << 20;
constexpr size_t WS_CTL = 0, CTL_ZERO_BYTES = 16384;
constexpr size_t WS_SSQ = 64 * 1024;
constexpr size_t WS_WGU = 1 * MiB;
constexpr size_t WS_WD = 45 * MiB;
constexpr size_t WS_WIN_E = 67 * MiB;
constexpr size_t WS_WQB = WS_WIN_E + 7680 * 1024;
constexpr size_t WS_WKVB = WS_WQB + 768 * 1024;
constexpr size_t WS_WOUT_E = 76 * MiB;
constexpr size_t WS_WIN_O = 80 * MiB;
constexpr size_t WS_WOUT_O = WS_WIN_O + 8704 * 1024;
constexpr size_t WS_MOD = 91 * MiB;
constexpr size_t WS_BIASV = WS_MOD + 512 * 1024;
constexpr int BV_IN_E = 4 * 4 * 5632, BV_IN_O = BV_IN_E + 4 * 3840;
constexpr size_t WS_CUM = 92 * MiB;
constexpr size_t WS_FLOG = 93 * MiB;
constexpr size_t WS_A = 94 * MiB;
constexpr size_t WS_C = 158 * MiB;
constexpr size_t WS_LAT = WS_C, WS_CQN = WS_C + 24 * MiB, WS_CKVN = WS_C + 36 * MiB, WS_OG = WS_C;
constexpr size_t WS_QAUG = WS_C + 32 * MiB, WS_KAUG = WS_C + 36 * MiB;
constexpr size_t WS_B = 202 * MiB;
constexpr size_t WS_KH = WS_B + 32 * MiB;
constexpr size_t WS_ACT = WS_B, WS_QK = WS_B, WS_VA = WS_B + 64 * MiB, WS_QB = WS_B, WS_KVB = WS_B + 24 * MiB, WS_KB = WS_B + 72 * MiB;
constexpr size_t WS_END = 298 * MiB;

__device__ __forceinline__ float bf2f(bf16 v) { return __uint_as_float((unsigned)v << 16); }
__device__ __forceinline__ unsigned pk2(float lo, float hi) { f32x2 v = {lo, hi}; bf16x2_t b = __builtin_convertvector(v, bf16x2_t); return __builtin_bit_cast(unsigned, b); }
__device__ __forceinline__ bf16 f2bf(float f) { return (bf16)(pk2(f, 0.f) & 0xffffu); }
__device__ __forceinline__ float wave_sum(float v) {
#pragma unroll
    for (int o = 1; o < 64; o <<= 1) v += __shfl_xor(v, o);
    return v;
}
__device__ __forceinline__ float half_sum(float v) {
#pragma unroll
    for (int o = 1; o < 32; o <<= 1) v += __shfl_xor(v, o);
    return v;
}
__device__ __forceinline__ float fexp2(float x) { return __builtin_amdgcn_exp2f(x); }
__device__ __forceinline__ float sigmoidf_(float x) { return __builtin_amdgcn_rcpf(1.0f + fexp2(-x * LOG2E)); }
__device__ __forceinline__ int crow(int i, int h) { return (i & 3) + 8 * (i >> 2) + 4 * h; }
#define LDS_WAIT() asm volatile("s_waitcnt lgkmcnt(0)" ::: "memory")
__device__ __forceinline__ float bf16r(float x) { return __uint_as_float(pk2(x, 0.f) << 16); }
__device__ __forceinline__ void split3(float x, float& hi, float& mid, float& lo) { hi = bf16r(x); const float r1 = x - hi; mid = bf16r(r1); lo = bf16r(r1 - mid); }
__device__ __forceinline__ bf16x8 split3frag(float x) { float a, b, c; split3(x, a, b, c); u32x4 w; w.x = pk2(a, b); w.y = pk2(c, 0.f); w.z = 0u; w.w = 0u; return __builtin_bit_cast(bf16x8, w); }

__device__ __forceinline__ float row_rinv(const float* __restrict__ ssq, int row) {
    const f32x4 q = *(const f32x4*)(ssq + (size_t)row * 4);
    return __builtin_amdgcn_rsqf(((q.x + q.y) + (q.z + q.w)) * (1.0f / DM) + EPS);
}
struct EpiSwiglu {
    static constexpr bool PERM = true, AFTER_DRAIN = false;
    bf16* O; int ldc; const float* ssq; const float* bias;
    __device__ __forceinline__ void operator()(const pg8::f32x4 (&acc)[2][2][4][2], const pg8::Unit& u, int wr, int wc, int fr, int fq) const {
        const int row0 = u.pm * 256 + wr * 64 + fr, col0 = u.pn * 128 + wc * 32 + 8 * fq;
        const float* bp = bias + (size_t)(u.pm >> 4) * 5632 + u.pn * 256 + wc * 32 + 8 * fq;
        const f32x4 bg0 = *(const f32x4*)bp, bg1 = *(const f32x4*)(bp + 4), bu0 = *(const f32x4*)(bp + 128), bu1 = *(const f32x4*)(bp + 132);
#pragma unroll
        for (int ai = 0; ai < 2; ++ai)
#pragma unroll
            for (int m = 0; m < 4; ++m) {
                const int row = row0 + ai * 128 + m * 16;
                const float rinv = row_rinv(ssq, row);
                bf16* rowp = O + (size_t)row * ldc + col0;
                float v[8];
#pragma unroll
                for (int n = 0; n < 2; ++n)
#pragma unroll
                    for (int e = 0; e < 4; ++e) {
                        const float g = acc[ai][0][m][n][e] * rinv + (n == 0 ? bg0[e] : bg1[e]), up = acc[ai][1][m][n][e] * rinv + (n == 0 ? bu0[e] : bu1[e]);
                        v[4 * n + e] = g * sigmoidf_(g) * up;
                    }
                u32x4 w; w.x = pk2(v[0], v[1]); w.y = pk2(v[2], v[3]); w.z = pk2(v[4], v[5]); w.w = pk2(v[6], v[7]);
                *(u32x4*)rowp = w;
            }
    }
};
struct EpiResid {
    static constexpr bool PERM = false, AFTER_DRAIN = true;
    unsigned char* ws; const float* x0; float* xbuf; int code;
    __device__ __forceinline__ void fused(pg8::f32x4 (&acc)[2][2][4][2], const pg8::Unit& u, int wr, int wc, int fr, int fq, LAS unsigned char* lds, int wid, int lane) const {
        const bool isdown = code & 1; const int sub = (code >> 1) & 1, l = code >> 2;
        const float* modl = (const float*)(ws + WS_MOD) + (size_t)l * 4 * NMOD;
        const float* scn = !isdown ? modl + 7 * DM : (sub == 0 ? modl + 4 * DM : (l == 0 ? modl + 4 * NMOD + 1 * DM : nullptr));
        const float* xin = (isdown && l == 0 && sub == 0) ? x0 : xbuf; float* xout = xbuf;
        const float* g = modl + (isdown ? (sub == 0 ? 2 : 8) : 5) * DM;
        const float coef = isdown ? 0.5f : 1.0f;
        bf16* xt = (bf16*)(ws + (isdown ? WS_A : WS_C)); float* ssq = (float*)(ws + WS_SSQ);
        const int b = u.pm >> 4, col0 = u.pn * 256 + wc * 32 + 4 * fq;
        const bool nxt = scn != nullptr;
        f32x4 gv[2][2], sv[2][2];
#pragma unroll
        for (int bj = 0; bj < 2; ++bj)
#pragma unroll
            for (int n = 0; n < 2; ++n) {
                gv[bj][n] = *(const f32x4*)(g + (size_t)b * NMOD + col0 + bj * 128 + n * 16) * coef;
                sv[bj][n] = nxt ? (*(const f32x4*)(scn + (size_t)b * NMOD + col0 + bj * 128 + n * 16) + 1.0f) : (f32x4){0.f, 0.f, 0.f, 0.f};
            }
        LAS float* P = (LAS float*)lds;
#pragma unroll
        for (int ai = 0; ai < 2; ++ai) {
            f32x4 xi[4][2][2];
#pragma unroll
            for (int m = 0; m < 4; ++m) {
                const size_t off = (size_t)(u.pm * 256 + ai * 128 + wr * 64 + m * 16 + fr) * DM + col0;
#pragma unroll
                for (int bj = 0; bj < 2; ++bj)
#pragma unroll
                    for (int n = 0; n < 2; ++n) xi[m][bj][n] = *(const f32x4*)(xin + off + bj * 128 + n * 16);
            }
            asm volatile("" ::: "memory");
#pragma unroll
            for (int m = 0; m < 4; ++m) {
                const int rl = ai * 128 + wr * 64 + m * 16 + fr;
                const size_t off = (size_t)(u.pm * 256 + rl) * DM + col0;
                float s = 0.f;
#pragma unroll
                for (int bj = 0; bj < 2; ++bj)
#pragma unroll
                    for (int n = 0; n < 2; ++n) {
                        const f32x4 xn = xi[m][bj][n] + gv[bj][n] * acc[ai][bj][m][n];
                        *(f32x4*)(xout + off + bj * 128 + n * 16) = xn;
                        if (nxt) {
                            s += (xn.x * xn.x + xn.y * xn.y) + (xn.z * xn.z + xn.w * xn.w);
                            const f32x4 y = xn * sv[bj][n];
                            u32x2 w; w.x = pk2(y.x, y.y); w.y = pk2(y.z, y.w);
                            *(u32x2*)(xt + off + bj * 128 + n * 16) = w;
                        }
                    }
                if (nxt) { s += __shfl_xor(s, 16); s += __shfl_xor(s, 32); if (fq == 0) P[rl * 4 + wc] = s; }
            }
        }
        if (nxt) {
            __syncthreads();
            const int t = wid * 64 + lane;
            if (t < 256) { const f32x4 p = *(LAS const f32x4*)(P + t * 4); ssq[(size_t)(u.pm * 256 + t) * 4 + u.pn] = (p.x + p.y) + (p.z + p.w); }
        }
    }
};
struct EpiStore {
    static constexpr bool PERM = true, AFTER_DRAIN = false;
    bf16 *b0, *b1, *b2, *b3; int l0, l1, l2, l3, t1, t2, t3, ft; float* fb; const float* ssq; const float* bias; int bn;
    int hm;
    __device__ __forceinline__ void operator()(const pg8::f32x4 (&acc)[2][2][4][2], const pg8::Unit& u, int wr, int wc, int fr, int fq) const {
        const int pn = u.pn, row0 = u.pm * 256 + wr * 64 + fr;
        const bool modn = ssq != nullptr;
        const float* bp = bias + (size_t)(u.pm >> 4) * bn + pn * 256 + wc * 32 + 8 * fq;
        pg8::f32x4 bv[2][2];
#pragma unroll
        for (int bj = 0; bj < 2; ++bj)
#pragma unroll
            for (int n = 0; n < 2; ++n) bv[bj][n] = modn ? *(const pg8::f32x4*)(bp + bj * 128 + 4 * n) : (pg8::f32x4){0.f, 0.f, 0.f, 0.f};
        if (pn == ft) {
            if (wc == 0 && fq < 2) {
#pragma unroll
                for (int ai = 0; ai < 2; ++ai)
#pragma unroll
                    for (int m = 0; m < 4; ++m) {
                        const int row = row0 + ai * 128 + m * 16; const float rinv = modn ? row_rinv(ssq, row) : 1.0f;
#pragma unroll
                        for (int n = 0; n < 2; ++n) *(pg8::f32x4*)(fb + (size_t)row * 16 + 8 * fq + 4 * n) = acc[ai][0][m][n] * rinv + bv[0][n];
                    }
            }
            return;
        }
        bf16* base; int ldc, ts, hd;
        if (pn < t1) { base = b0; ldc = l0; ts = 0; hd = hm & 255; } else if (pn < t2) { base = b1; ldc = l1; ts = t1; hd = (hm >> 8) & 255; } else if (pn < t3) { base = b2; ldc = l2; ts = t2; hd = (hm >> 16) & 255; } else { base = b3; ldc = l3; ts = t3; hd = (hm >> 24) & 255; }
        const int col0 = (pn - ts) * 256 + wc * 32 + 8 * fq;
        size_t coff[2];
#pragma unroll
        for (int bj = 0; bj < 2; ++bj) { const int c = col0 + bj * 128; if (hd == 0) coff[bj] = (size_t)c; else { const int head = c / hd; coff[bj] = (size_t)head * SEQ * hd + (c - head * hd); } }
#pragma unroll
        for (int ai = 0; ai < 2; ++ai)
#pragma unroll
            for (int m = 0; m < 4; ++m) {
                const int row = row0 + ai * 128 + m * 16; const float rinv = modn ? row_rinv(ssq, row) : 1.0f;
                bf16* rowp = base + (hd == 0 ? (size_t)row * ldc : (size_t)(row >> 12) * SEQ * ldc + (size_t)(row & (SEQ - 1)) * hd);
#pragma unroll
                for (int bj = 0; bj < 2; ++bj) {
                    const pg8::f32x4 v0 = acc[ai][bj][m][0] * rinv + bv[bj][0], v1 = acc[ai][bj][m][1] * rinv + bv[bj][1];
                    u32x4 w; w.x = pk2(v0[0], v0[1]); w.y = pk2(v0[2], v0[3]); w.z = pk2(v1[0], v1[1]); w.w = pk2(v1[2], v1[3]);
                    *(u32x4*)(rowp + coff[bj]) = w;
                }
            }
    }
};

__device__ __forceinline__ void transpose_item(const float* __restrict__ W, int K, int ldw, int nblk, bf16* __restrict__ WT, int mode, LAS float* scr, int item, int lane) {
    const int kb = item / nblk, nb = item - kb * nblk, k0 = 64 * kb, n0 = 32 * nb;
#pragma unroll 8
    for (int i = 0; i < 32; ++i) { const int kk = 2 * i + (lane >> 5); scr[kk * 33 + (lane & 31)] = W[(size_t)(k0 + kk) * ldw + n0 + (lane & 31)]; }
    LDS_WAIT();
    const int c = lane & 7;
#pragma unroll
    for (int j = 0; j < 4; ++j) {
        const int n = (lane >> 3) + 8 * j, gn = n0 + n;
        const int row = mode == 0 ? gn : ((gn >> 7) * 256 + (gn & 127) + (mode == 2 ? 128 : 0));
        const LAS float* s = scr + (8 * c) * 33 + n;
        u32x4 o; o.x = pk2(s[0 * 33], s[1 * 33]); o.y = pk2(s[2 * 33], s[3 * 33]); o.z = pk2(s[4 * 33], s[5 * 33]); o.w = pk2(s[6 * 33], s[7 * 33]);
        *(u32x4*)(WT + (size_t)row * K + k0 + 8 * c) = o;
    }
    LDS_WAIT();
}

struct Args { const float* in[31]; float* out; unsigned char* ws; int ph_lo, ph_hi; };
struct Ctx { int tid, bid, G, zi; unsigned char* ws; };
#define INP(k) (a.in[(k) + cx.zi])

__device__ __forceinline__ void prologue_phase(const Args& a, const Ctx& cx, LAS unsigned char* lds) {
    unsigned char* ws = cx.ws;
    const int tid = cx.tid, lane = tid & 63, wave = tid >> 6, G = cx.G;
    const int gw = cx.bid * NWAVES + wave, NGW = G * NWAVES;
    LAS float* scr = (LAS float*)(lds + wave * 8704);
    constexpr int I_FF = 1408, N_FF = 12 * I_FF;
    constexpr int I_INE = 16 * 117, I_QB = 6 * 24, I_KVB = 4 * 48, I_OUTE = 32 * 32, I_INO = 16 * 128, I_OUTO = 16 * 32;
    constexpr int NITEMS = N_FF + I_INE + I_QB + I_KVB + I_OUTE + I_INO + I_OUTO;
    for (int it = gw; it < NITEMS; it += NGW) {
        int r = it;
        if (r < N_FF) {
            const int id = r / I_FF, item = r - id * I_FF, lf = id / 3, which = id - lf * 3, l = lf >> 1, f = lf & 1;
            if (which < 2) transpose_item(INP(5 + f * 3 + which) + (size_t)l * DM * FF, DM, FF, FF / 32, (bf16*)(ws + WS_WGU) + (size_t)lf * 5632 * 1024, 1 + which, scr, item, lane);
            else transpose_item(INP(7 + f * 3) + (size_t)l * FF * DM, FF, DM, DM / 32, (bf16*)(ws + WS_WD) + (size_t)lf * 1024 * 2816, 0, scr, item, lane);
            continue;
        }
        r -= N_FF;
        if (r < I_INE) { transpose_item(INP(11), 1024, 3744, 117, (bf16*)(ws + WS_WIN_E), 0, scr, r, lane); continue; } r -= I_INE;
        if (r < I_QB) { transpose_item(INP(12), 384, 768, 24, (bf16*)(ws + WS_WQB), 0, scr, r, lane); continue; } r -= I_QB;
        if (r < I_KVB) { transpose_item(INP(13), 256, 1536, 48, (bf16*)(ws + WS_WKVB), 0, scr, r, lane); continue; } r -= I_KVB;
        if (r < I_OUTE) { transpose_item(INP(25), 2048, 1024, 32, (bf16*)(ws + WS_WOUT_E), 0, scr, r, lane); continue; } r -= I_OUTE;
        if (r < I_INO) { transpose_item(INP(26), 1024, 4112, 128, (bf16*)(ws + WS_WIN_O), 0, scr, r, lane); continue; } r -= I_INO;
        transpose_item(INP(30), 1024, 1024, 32, (bf16*)(ws + WS_WOUT_O), 0, scr, r, lane);
    }
    for (int i = cx.bid * NTHR + tid; i < 16 * 1024; i += G * NTHR) { const int n = i >> 10, k = i & 1023; ((bf16*)(ws + WS_WIN_O))[(size_t)(4096 + n) * 1024 + k] = f2bf(INP(26)[(size_t)k * 4112 + 4096 + n]); }
    __syncthreads();
    LAS float* sc = (LAS float*)(lds + 73728);
    LAS float* part = (LAS float*)(lds + 90112);
    for (int bi = cx.bid; bi < 144; bi += G) {
        const int l = bi / 72, n0 = (bi - l * 72) * 128;
        for (int i = tid; i < 4096; i += NTHR) { const float v = INP(1)[i]; sc[i] = v * sigmoidf_(v); }
        __syncthreads();
        float acc[4][2];
#pragma unroll
        for (int b = 0; b < 4; ++b) { acc[b][0] = 0.f; acc[b][1] = 0.f; }
        const float* wp = INP(3) + ((size_t)l * 1024 + wave * 128) * NMOD + n0 + 2 * lane;
#pragma unroll 8
        for (int k = 0; k < 128; ++k) {
            const f32x2 wv = *(const f32x2*)(wp + (size_t)k * NMOD);
#pragma unroll
            for (int b = 0; b < 4; ++b) { const float s = sc[b * 1024 + wave * 128 + k]; acc[b][0] += s * wv.x; acc[b][1] += s * wv.y; }
        }
#pragma unroll
        for (int b = 0; b < 4; ++b) { part[(wave * 4 + b) * 128 + 2 * lane] = acc[b][0]; part[(wave * 4 + b) * 128 + 2 * lane + 1] = acc[b][1]; }
        __syncthreads();
        { const int b = tid >> 7, col = tid & 127; float s = INP(4)[(size_t)l * NMOD + n0 + col];
#pragma unroll
          for (int w = 0; w < 8; ++w) s += part[(w * 4 + b) * 128 + col];
          ((float*)(ws + WS_MOD))[(size_t)(l * 4 + b) * NMOD + n0 + col] = s; }
        __syncthreads();
    }
}

__device__ __forceinline__ void mod0_phase(const Args& a, const Ctx& cx) {
    unsigned char* ws = cx.ws;
    const int tid = cx.tid, lane = tid & 63, wave = tid >> 6;
    const int gw = cx.bid * NWAVES + wave, NGW = cx.G * NWAVES;
    const float* x = INP(0); const float* mod = (const float*)(ws + WS_MOD);
    bf16* XT = (bf16*)(ws + WS_A); float* ssq = (float*)(ws + WS_SSQ);
    for (int row = gw; row < T; row += NGW) {
        const int b = row >> 12;
        const float* scp = mod + (size_t)b * NMOD + DM;
        const f32x4* xr = (const f32x4*)(x + (size_t)row * DM) + lane;
        f32x4 v[4]; float ss = 0.f;
#pragma unroll
        for (int j = 0; j < 4; ++j) { v[j] = xr[64 * j]; ss += (v[j].x * v[j].x + v[j].y * v[j].y) + (v[j].z * v[j].z + v[j].w * v[j].w); }
        ss = wave_sum(ss);
        if (lane == 0) *(f32x4*)(ssq + (size_t)row * 4) = (f32x4){ss, 0.f, 0.f, 0.f};
        u32x2* o8 = (u32x2*)(XT + (size_t)row * DM) + lane;
#pragma unroll
        for (int j = 0; j < 4; ++j) {
            const f32x4 s4 = *((const f32x4*)scp + lane + 64 * j);
            const f32x4 y = v[j] * (s4 + 1.0f);
            u32x2 w; w.x = pk2(y.x, y.y); w.y = pk2(y.z, y.w); o8[64 * j] = w;
        }
    }
    for (int mi = 0; mi < 6; ++mi) {
        const int l = mi / 3, w3 = mi - l * 3;
        const bf16* Wt; int N; float* out;
        if (w3 == 1) { Wt = (const bf16*)(ws + (l == 0 ? WS_WIN_E : WS_WIN_O)); N = l == 0 ? 3840 : 4352; out = (float*)(ws + WS_BIASV) + (l == 0 ? BV_IN_E : BV_IN_O); }
        else { const int lf = l * 2 + (w3 >> 1); Wt = (const bf16*)(ws + WS_WGU) + (size_t)lf * 5632 * 1024; N = 5632; out = (float*)(ws + WS_BIASV) + (size_t)lf * 4 * 5632; }
        f32x4 sh[4][4];
#pragma unroll
        for (int b = 0; b < 4; ++b)
#pragma unroll
            for (int j = 0; j < 4; ++j) sh[b][j] = *(const f32x4*)(mod + (size_t)(l * 4 + b) * NMOD + (3 * w3) * DM + 16 * lane + 4 * j);
        u32x4 w0 = {0u, 0u, 0u, 0u}, w1 = {0u, 0u, 0u, 0u};
        if (gw < N) { w0 = *(const u32x4*)(Wt + (size_t)gw * 1024 + 16 * lane); w1 = *(const u32x4*)(Wt + (size_t)gw * 1024 + 16 * lane + 8); }
        for (int n = gw; n < N; n += NGW) {
            const int nn = n + NGW < N ? n + NGW : n;
            const u32x4 nw0 = *(const u32x4*)(Wt + (size_t)nn * 1024 + 16 * lane), nw1 = *(const u32x4*)(Wt + (size_t)nn * 1024 + 16 * lane + 8);
            float wf[16];
#pragma unroll
            for (int e = 0; e < 4; ++e) { wf[2 * e] = __uint_as_float(w0[e] << 16); wf[2 * e + 1] = __uint_as_float(w0[e] & 0xffff0000u); wf[8 + 2 * e] = __uint_as_float(w1[e] << 16); wf[8 + 2 * e + 1] = __uint_as_float(w1[e] & 0xffff0000u); }
            float sb[4];
#pragma unroll
            for (int b = 0; b < 4; ++b) { float s_ = 0.f;
#pragma unroll
                for (int j = 0; j < 4; ++j) s_ += (sh[b][j].x * wf[4 * j] + sh[b][j].y * wf[4 * j + 1]) + (sh[b][j].z * wf[4 * j + 2] + sh[b][j].w * wf[4 * j + 3]);
                sb[b] = s_; }
            const bool h5 = lane & 32, h4 = lane & 16;
            const float t0 = (h5 ? sb[2] : sb[0]) + __shfl_xor(h5 ? sb[0] : sb[2], 32);
            const float t1 = (h5 ? sb[3] : sb[1]) + __shfl_xor(h5 ? sb[1] : sb[3], 32);
            float u_ = (h4 ? t1 : t0) + __shfl_xor(h4 ? t0 : t1, 16);
            u_ += __shfl_xor(u_, 8); u_ += __shfl_xor(u_, 4); u_ += __shfl_xor(u_, 2); u_ += __shfl_xor(u_, 1);
            if ((lane & 15) == 0) out[(size_t)(((lane >> 5) & 1) * 2 + ((lane >> 4) & 1)) * N + n] = u_;
            w0 = nw0; w1 = nw1;
        }
    }
}

__constant__ const double ROPE_REV64[32] = {0.15915494309189535, 0.11934937021124886, 0.08949940160889101, 0.06711508300522726, 0.050329212104487035, 0.03774158471741977, 0.0283021958306234, 0.02122365276477766, 0.015915494309189534, 0.011934937021124886, 0.008949940160889102, 0.006711508300522725, 0.005032921210448704, 0.003774158471741977, 0.00283021958306234, 0.0021223652764777662, 0.0015915494309189536, 0.0011934937021124885, 0.0008949940160889102, 0.0006711508300522726, 0.0005032921210448703, 0.00037741584717419774, 0.00028302195830623395, 0.0002122365276477766, 0.00015915494309189535, 0.00011934937021124886, 8.949940160889102e-05, 6.711508300522725e-05, 5.0329212104487035e-05, 3.774158471741978e-05, 2.8302195830623396e-05, 2.122365276477766e-05};
__constant__ const double ROPE_REV32[16] = {0.15915494309189535, 0.08949940160889101, 0.050329212104487035, 0.0283021958306234, 0.015915494309189534, 0.008949940160889102, 0.005032921210448704, 0.00283021958306234, 0.0015915494309189536, 0.0008949940160889102, 0.0005032921210448703, 0.00028302195830623395, 0.00015915494309189535, 8.949940160889102e-05, 5.0329212104487035e-05, 2.8302195830623396e-05};
__device__ __forceinline__ void rope_cs(int pos, int i, int dim, float& c, float& s) {
    const double rev = (double)pos * (dim == 64 ? ROPE_REV64[i] : ROPE_REV32[i]);
    const float fr = (float)__builtin_amdgcn_fract(rev);
    s = __builtin_amdgcn_sinf(fr); c = __builtin_amdgcn_cosf(fr);
}

__device__ __forceinline__ void unpack8(const u32x4 w, float (&x)[8]) {
#pragma unroll
    for (int e = 0; e < 4; ++e) { x[2 * e] = __uint_as_float(w[e] << 16); x[2 * e + 1] = __uint_as_float(w[e] & 0xffff0000u); }
}
__device__ __forceinline__ u32x4 pack8(const float (&x)[8]) { u32x4 w; w.x = pk2(x[0], x[1]); w.y = pk2(x[2], x[3]); w.z = pk2(x[4], x[5]); w.w = pk2(x[6], x[7]); return w; }
template <bool ROPE>
__device__ __forceinline__ void prep_qk_token(bf16* __restrict__ qk, const float* __restrict__ gq, const float* __restrict__ gk, float qscale, int pos, int lane) {
    const int cc = lane & 7;
    float cs[8], sn[8], gqv[8], gkv[8];
#pragma unroll
    for (int e = 0; e < 8; ++e) { gqv[e] = gq[8 * cc + e]; gkv[e] = gk[8 * cc + e]; cs[e] = 1.f; sn[e] = 0.f; if (ROPE) rope_cs(pos, (8 * cc + e) & 31, 64, cs[e], sn[e]); }
    u32x4 raw[4];
#pragma unroll
    for (int j = 0; j < 4; ++j) raw[j] = *((const u32x4*)qk + lane + 64 * j);
#pragma unroll
    for (int j = 0; j < 4; ++j) {
        u32x4* p = (u32x4*)qk + lane + 64 * j;
        float x[8]; unpack8(raw[j], x);
        float ss = 0.f;
#pragma unroll
        for (int e = 0; e < 8; ++e) ss += x[e] * x[e];
        ss += __shfl_xor(ss, 1); ss += __shfl_xor(ss, 2); ss += __shfl_xor(ss, 4);
        const float rinv = __builtin_amdgcn_rsqf(ss * (1.0f / 64.0f) + EPS);
        const bool isq = j < 2;
        float o[8];
#pragma unroll
        for (int e = 0; e < 8; ++e) {
            const float y = x[e] * rinv * (isq ? gqv[e] : gkv[e]);
            float r = y;
            if (ROPE) { const float pr = __shfl_xor(y, 4); r = (cc < 4) ? (y * cs[e] - pr * sn[e]) : (y * cs[e] + pr * sn[e]); }
            o[e] = isq ? r * qscale : r;
        }
        *p = pack8(o);
    }
}

__device__ __forceinline__ void prep1e_phase(const Args& a, const Ctx& cx) {
    unsigned char* ws = cx.ws;
    const int tid = cx.tid, lane = tid & 63, wave = tid >> 6;
    const int gw = cx.bid * NWAVES + wave, NGW = cx.G * NWAVES;
    const int* positions = (const int*)INP(2);
    const float qscale = 0.125f * LOG2E;
    for (int t = gw; t < T; t += NGW) {
        prep_qk_token<true>((bf16*)(ws + WS_QK) + (size_t)t * 2048, INP(16), INP(17), qscale, positions[t], lane);
        const u32x4* lat = (const u32x4*)((const bf16*)(ws + WS_LAT) + (size_t)t * 768);
        {
            float x[8]; float ss = 0.f;
            if (lane < 48) { unpack8(lat[lane], x);
#pragma unroll
                for (int e = 0; e < 8; ++e) ss += x[e] * x[e]; }
            const float rinv = __builtin_amdgcn_rsqf(wave_sum(ss) * (1.0f / 384.0f) + EPS);
            if (lane < 48) { float o[8];
#pragma unroll
                for (int e = 0; e < 8; ++e) o[e] = x[e] * rinv * INP(14)[8 * lane + e];
                ((u32x4*)((bf16*)(ws + WS_CQN) + (size_t)t * 384))[lane] = pack8(o); }
        }
        {
            float x[8]; float ss = 0.f;
            if (lane < 32) { unpack8(lat[48 + lane], x);
#pragma unroll
                for (int e = 0; e < 8; ++e) ss += x[e] * x[e]; }
            const float rinv = __builtin_amdgcn_rsqf(wave_sum(ss) * (1.0f / 256.0f) + EPS);
            if (lane < 32) { float o[8];
#pragma unroll
                for (int e = 0; e < 8; ++e) o[e] = x[e] * rinv * INP(15)[8 * lane + e];
                ((u32x4*)((bf16*)(ws + WS_CKVN) + (size_t)t * 256))[lane] = pack8(o); }
        }
    }
}

__device__ __forceinline__ void prep2e_phase(const Args& a, const Ctx& cx) {
    unsigned char* ws = cx.ws;
    const int tid = cx.tid, lane = tid & 63, wave = tid >> 6;
    const int gw = cx.bid * NWAVES + wave, NGW = cx.G * NWAVES;
    const int* positions = (const int*)INP(2);
    const int cl = lane & 15, grp = lane >> 4;
    const bool act = cl < 12, isr = cl >= 8;
    const float qscale = 0.10206207261596575f * LOG2E;
    float gqv[8], gkv[8];
#pragma unroll
    for (int e = 0; e < 8; ++e) { gqv[e] = act ? INP(18)[8 * cl + e] : 0.f; gkv[e] = act ? INP(19)[8 * cl + e] : 0.f; }
    for (int t = gw; t < T; t += NGW) {
        const int pos = positions[t];
        float cs[8], sn[8];
#pragma unroll
        for (int e = 0; e < 8; ++e) rope_cs(pos, 8 * (cl & 1) + e, 32, cs[e], sn[e]);
        bf16* qb = (bf16*)(ws + WS_QB) + (size_t)t * 768;
        const bf16* kvb = (const bf16*)(ws + WS_KVB) + (size_t)t * 1536;
        const bf16* lat = (const bf16*)(ws + WS_LAT) + (size_t)t * 768;
        bf16* kbo = (bf16*)(ws + WS_KB) + (size_t)t * 768;
#pragma unroll
        for (int j = 0; j < 2; ++j) {
            const int head = 4 * j + grp;
#pragma unroll
            for (int qk = 0; qk < 2; ++qk) {
                float x[8];
#pragma unroll
                for (int e = 0; e < 8; ++e) x[e] = 0.f;
                if (act) {
                    if (qk == 0) unpack8(*(const u32x4*)(qb + head * 96 + 8 * cl), x);
                    else if (!isr) unpack8(*(const u32x4*)(kvb + head * 192 + 8 * cl), x);
                    else unpack8(*(const u32x4*)(lat + 640 + 8 * (cl - 8)), x);
                }
                float ss = 0.f;
#pragma unroll
                for (int e = 0; e < 8; ++e) ss += x[e] * x[e];
                ss += __shfl_xor(ss, 1); ss += __shfl_xor(ss, 2); ss += __shfl_xor(ss, 4); ss += __shfl_xor(ss, 8);
                const float rinv = __builtin_amdgcn_rsqf(ss * (1.0f / 96.0f) + EPS);
                float o[8];
#pragma unroll
                for (int e = 0; e < 8; ++e) {
                    const float y = x[e] * rinv * (qk == 0 ? gqv[e] : gkv[e]);
                    const float pr = __shfl_xor(y, 2);
                    float r = y;
                    if (isr) r = (cl < 10) ? (y * cs[e] - pr * sn[e]) : (y * cs[e] + pr * sn[e]);
                    o[e] = qk == 0 ? r * qscale : r;
                }
                if (act) { if (qk == 0) *(u32x4*)(qb + head * 96 + 8 * cl) = pack8(o); else *(u32x4*)(kbo + head * 96 + 8 * cl) = pack8(o); }
            }
        }
    }
}

__device__ __forceinline__ void prepo_phase(const Args& a, const Ctx& cx, LAS unsigned char* lds) {
    unsigned char* ws = cx.ws;
    const int tid = cx.tid, lane = tid & 63, wave = tid >> 6;
    const int gw = cx.bid * NWAVES + wave, NGW = cx.G * NWAVES;
    const float qscale = 0.125f * LOG2E;
    {
        const int cc = lane & 7;
        float gqv[8], gkv[8];
#pragma unroll
        for (int e = 0; e < 8; ++e) { gqv[e] = INP(28)[8 * cc + e] * qscale; gkv[e] = INP(29)[8 * cc + e]; }
        for (int t = gw; t < T; t += NGW) {
            const int b = t >> 12, sq_ = t & (SEQ - 1);
            u32x4* pp[4]; u32x4 raw[4];
#pragma unroll
            for (int j = 0; j < 4; ++j) {
                const int v = (lane >> 3) + 8 * j;
                pp[j] = (j < 2) ? (u32x4*)((bf16*)(ws + WS_QK) + (size_t)t * 1024 + v * 64 + 8 * cc)
                                : (u32x4*)((bf16*)(ws + WS_KH) + ((size_t)(b * 16 + v - 16) * SEQ + sq_) * 64 + 8 * cc);
                raw[j] = *pp[j];
            }
#pragma unroll
            for (int j = 0; j < 4; ++j) {
                u32x4* p = pp[j];
                float x[8]; unpack8(raw[j], x);
                float ss = 0.f;
#pragma unroll
                for (int e = 0; e < 8; ++e) ss += x[e] * x[e];
                ss += __shfl_xor(ss, 1); ss += __shfl_xor(ss, 2); ss += __shfl_xor(ss, 4);
                const float rinv = __builtin_amdgcn_rsqf(ss * (1.0f / 64.0f) + EPS);
                float o[8];
#pragma unroll
                for (int e = 0; e < 8; ++e) o[e] = x[e] * rinv * (j < 2 ? gqv[e] : gkv[e]);
                *p = pack8(o);
            }
        }
    }
    LAS double* sd = (LAS double*)lds;
    for (int sq = cx.bid; sq < 64; sq += cx.G) {
        const int b = sq >> 4, hd = sq & 15; const float bfv = INP(27)[hd];
        const float* F = (const float*)(ws + WS_FLOG) + ((size_t)b * SEQ + 8 * tid) * 16 + hd;
        double pre[8]; double run = 0.0;
#pragma unroll
        for (int e = 0; e < 8; ++e) { const float z = F[e * 16] + bfv; const float lf = fminf(z, 0.f) - __logf(1.0f + __expf(-fabsf(z))); run += (double)lf; pre[e] = run; }
        __syncthreads();
        sd[tid] = run; __syncthreads();
        int cur = 0;
        for (int off = 1; off < 512; off <<= 1) { double v = sd[cur * 512 + tid]; if (tid >= off) v += sd[cur * 512 + tid - off]; sd[(cur ^ 1) * 512 + tid] = v; __syncthreads(); cur ^= 1; }
        const double excl = sd[cur * 512 + tid] - run;
        u32x4* QA = (u32x4*)((bf16*)(ws + WS_QAUG) + ((size_t)sq * SEQ + 8 * tid) * 8);
        u32x4* KA = (u32x4*)((bf16*)(ws + WS_KAUG) + ((size_t)sq * SEQ + 8 * tid) * 16);
#pragma unroll
        for (int e = 0; e < 8; ++e) {
            const float c = (float)((excl + pre[e]) * (double)LOG2E);
            float c0, c1, c2; split3(c, c0, c1, c2);
            u32x4 qa; qa.x = pk2(c0, c1); qa.y = pk2(c2, 1.f); qa.z = pk2(1.f, 1.f); qa.w = 0u;
            u32x4 k0; k0.x = pk2(1.f, 1.f); k0.y = pk2(1.f, -c0); k0.z = pk2(-c1, -c2); k0.w = 0u;
            u32x4 k1; k1.x = pk2(1.f, 1.f); k1.y = pk2(1.f, 0.f); k1.z = 0u; k1.w = 0u;
            QA[e] = qa; KA[2 * e] = k0; KA[2 * e + 1] = k1;
        }
        __syncthreads();
    }
}

#define MFMA32(a, b, c) __builtin_amdgcn_mfma_f32_32x32x16_bf16((a), (b), (c), 0, 0, 0)
typedef short v4i16_t __attribute__((ext_vector_type(4)));
__device__ __forceinline__ s16x4 vtr(LAS const unsigned char* p) { return __builtin_bit_cast(s16x4, __builtin_amdgcn_ds_read_tr16_b64_v4i16((LAS v4i16_t*)p)); }

template <int DKT>
__device__ __forceinline__ void qk_tile_plain(f32x16 (&sa)[2], LAS const unsigned char* kbase, const bf16x8 (&q)[DKT / 16], int r, int h) {
    constexpr int KSTR = DKT + 8;
#pragma unroll
    for (int kb = 0; kb < 2; ++kb) {
#pragma unroll
        for (int i = 0; i < 16; ++i) sa[kb][i] = 0.f;
#pragma unroll
        for (int s = 0; s < DKT / 16; ++s) { const bf16x8 kf = *(LAS const bf16x8*)(kbase + ((32 * kb + r) * KSTR + 16 * s + 8 * h) * 2); sa[kb] = MFMA32(kf, q[s], sa[kb]); }
    }
}
__device__ __forceinline__ float max3f(float a, float b, float c) { return fmaxf(fmaxf(a, b), c); }

constexpr float ATT_THR = 8.0f;
#ifndef ATT_DEEP
#define ATT_DEEP(DK, DV) ((DK) == 64)
#endif
template <int DK, int DV, bool AUG>
__device__ __forceinline__ void attn_pass(const Ctx& cx, LAS unsigned char* lds, const bf16* __restrict__ Qg, int qp, const bf16* __restrict__ Kg, int kp, const bf16* __restrict__ Vg, int vp,
                                          const bf16* __restrict__ qaug, const bf16* __restrict__ kaug, int qb, f32x16 (&o)[DV / 32]) {
    constexpr int DKT = DK + (AUG ? 16 : 0), KSTR = DKT + 8, VSTR = DV + 32, KBY = 64 * KSTR * 2, VBY = 64 * VSTR * 2;
    constexpr int OFF_K = 0, OFF_V = 2 * KBY, ATT_BYTES = 2 * KBY + 2 * VBY;
    constexpr int KCPR = DK / 8, VCPR = DV / 8, NKC = 64 * KCPR, NVC = 64 * VCPR, NS = DKT / 16, NQK = 2 * NS;
    static_assert(ATT_BYTES <= LDS_MAIN && (DK != 64 || DV != 128 || ATT_BYTES <= 65536), "attention LDS (the differential pass parks its first map at 64 KiB)");
    const int tid = cx.tid, lane = tid & 63, r = lane & 31, h = lane >> 5, wid = __builtin_amdgcn_readfirstlane(tid >> 6);
    const int R0 = qb * 256 + wid * 32;
    const GAS bf16* Qg1 = (const GAS bf16*)Qg; const GAS bf16* Kg1 = (const GAS bf16*)Kg; const GAS bf16* Vg1 = (const GAS bf16*)Vg; const GAS bf16* qaug1 = (const GAS bf16*)qaug; const GAS bf16* kaug1 = (const GAS bf16*)kaug;
    bf16x8 q[NS];
#pragma unroll
    for (int s = 0; s < DK / 16; ++s) q[s] = *(const GAS bf16x8*)(Qg1 + (size_t)(R0 + r) * qp + 16 * s + 8 * h);
    if (AUG) { q[NS - 1] = (bf16x8){0, 0, 0, 0, 0, 0, 0, 0}; if (h == 0) q[NS - 1] = *(const GAS bf16x8*)(qaug1 + (size_t)(R0 + r) * 8); }
#pragma unroll
    for (int d = 0; d < DV / 32; ++d)
#pragma unroll
        for (int i = 0; i < 16; ++i) o[d][i] = 0.f;
    float m = AUG ? 0.f : -1e30f, lsum = 0.f;
    const int nt = 4 * (qb + 1), jmax = 4 * qb + (wid >> 1);
    const int krow0 = tid / KCPR, kcol0 = (tid - krow0 * KCPR) * 8, krow1 = (tid + 512) / KCPR, kcol1 = ((tid + 512) - krow1 * KCPR) * 8;
    const int vrow0 = tid / VCPR, vcol0 = (tid - vrow0 * VCPR) * 8, vrow1 = (tid + 512) / VCPR, vcol1 = ((tid + 512) - vrow1 * VCPR) * 8;
    const bool k1 = (NKC > 512) && (tid + 512 < NKC);
    u32x4 kr0_0, kr1_0 = {0u, 0u, 0u, 0u}, vr0_0, vr1_0 = {0u, 0u, 0u, 0u}, ka_0 = {0u, 0u, 0u, 0u};
    u32x4 kr0_1, kr1_1 = {0u, 0u, 0u, 0u}, vr0_1, vr1_1 = {0u, 0u, 0u, 0u}, ka_1 = {0u, 0u, 0u, 0u};
    const int krow1c = krow1 < 64 ? krow1 : 63, karow = (tid >> 1) & 63;
#define ATT_LOADK(j, S) do { const size_t kb_ = (size_t)(j) * 64; \
        kr0_##S = *(const GAS u32x4*)(Kg1 + (kb_ + krow0) * kp + kcol0); if (NKC > 512) kr1_##S = *(const GAS u32x4*)(Kg1 + (kb_ + krow1c) * kp + kcol1); \
        if (AUG) ka_##S = *(const GAS u32x4*)(kaug1 + (kb_ + karow) * 16 + (tid & 1) * 8); } while (0)
#define ATT_LOADV(j, S) do { const size_t kb_ = (size_t)(j) * 64; \
        vr0_##S = *(const GAS u32x4*)(Vg1 + (kb_ + vrow0) * vp + vcol0); if (NVC > 512) vr1_##S = *(const GAS u32x4*)(Vg1 + (kb_ + vrow1) * vp + vcol1); } while (0)
#define ATT_STOREK(buf, S) do { LAS unsigned char* b_ = lds + OFF_K + (buf) * KBY; \
        *(LAS u32x4*)(b_ + (krow0 * KSTR + kcol0) * 2) = kr0_##S; if (k1) *(LAS u32x4*)(b_ + (krow1 * KSTR + kcol1) * 2) = kr1_##S; \
        if (AUG && tid < 128) *(LAS u32x4*)(b_ + ((tid >> 1) * KSTR + DK + (tid & 1) * 8) * 2) = ka_##S; } while (0)
#define ATT_STOREV(buf, S) do { LAS unsigned char* b_ = lds + OFF_V + (buf) * VBY; \
        *(LAS u32x4*)(b_ + (vrow0 * VSTR + vcol0) * 2) = vr0_##S; if (NVC > 512) *(LAS u32x4*)(b_ + (vrow1 * VSTR + vcol1) * 2) = vr1_##S; } while (0)
    constexpr bool DEEP = ATT_DEEP(DK, DV);
    ATT_LOADK(0, 0); ATT_LOADV(0, 0); ATT_STOREK(0, 0); ATT_STOREV(0, 0);
    ATT_LOADK(1, 0); ATT_STOREK(1, 0);
    if (DEEP) { ATT_LOADK(2, 1); ATT_LOADV(1, 1); }
    __syncthreads();
    f32x16 sc[2], sn[2];
    qk_tile_plain<DKT>(sc, lds + OFF_K, q, r, h);
    __syncthreads();
    const int voff = (((lane & 15) >> 2) + 4 * h) * VSTR * 2 + ((lane >> 4) & 1) * 32 + (lane & 3) * 8;
    const int koff = (r * KSTR + 8 * h) * 2;
    for (int j2 = 0; j2 < nt; j2 += 2) {
#pragma unroll
      for (int half = 0; half < 2; ++half) {
        const int j = j2 + half;
        constexpr int LA = DEEP ? 1 : 0;
        if (DEEP) {
            if (half == 0) { ATT_STOREK(0, 1); ATT_STOREV(1, 1); } else { ATT_STOREK(1, 0); ATT_STOREV(0, 0); }
        }
        { const int jk = (j + 2 + LA < nt) ? j + 2 + LA : nt - 1, jv = (j + 1 + LA < nt) ? j + 1 + LA : nt - 1;
          if (half == 0) { ATT_LOADK(jk, 0); ATT_LOADV(jv, 0); } else { ATT_LOADK(jk, 1); ATT_LOADV(jv, 1); } }
        if (j <= jmax) {
            LAS const unsigned char* kn = lds + OFF_K + ((j + 1) & 1) * KBY + koff;
            LAS const unsigned char* vbase = lds + OFF_V + (j & 1) * VBY + voff;
            if (j == jmax) {
                const int qrow = R0 + r;
#pragma unroll
                for (int kb = 0; kb < 2; ++kb)
#pragma unroll
                    for (int i = 0; i < 16; ++i) { const int key = 64 * j + 32 * kb + crow(i, h); if (key > qrow) sc[kb][i] = -1e30f; }
            }
            float mx = max3f(sc[0][0], sc[0][1], sc[1][0]);
#pragma unroll
            for (int i = 2; i < 16; i += 2) mx = max3f(mx, sc[0][i], sc[0][i + 1]);
#pragma unroll
            for (int i = 1; i < 15; i += 2) mx = max3f(mx, sc[1][i], sc[1][i + 1]);
            mx = fmaxf(mx, sc[1][15]);
            mx = fmaxf(mx, __shfl_xor(mx, 32));
            if (AUG) {
                if (__builtin_amdgcn_ballot_w64(mx > ATT_THR) != 0ull) {
                    const float dlt = fmaxf(mx, 0.f), alpha = fexp2(-dlt); m += dlt; lsum *= alpha;
#pragma unroll
                    for (int d = 0; d < DV / 32; ++d)
#pragma unroll
                        for (int i = 0; i < 16; ++i) o[d][i] *= alpha;
#pragma unroll
                    for (int kb = 0; kb < 2; ++kb)
#pragma unroll
                        for (int i = 0; i < 16; ++i) sc[kb][i] -= dlt;
                    const bf16x8 mf = split3frag(-m);
                    if (h == 1) q[NS - 1] = mf;
                }
            } else if (__builtin_amdgcn_ballot_w64(mx > m + ATT_THR) != 0ull) {
                const float mn = fmaxf(m, mx), alpha = fexp2(m - mn); m = mn; lsum *= alpha;
#pragma unroll
                for (int d = 0; d < DV / 32; ++d)
#pragma unroll
                    for (int i = 0; i < 16; ++i) o[d][i] *= alpha;
            }
#pragma unroll
            for (int kb = 0; kb < 2; ++kb)
#pragma unroll
                for (int i = 0; i < 16; ++i) sn[kb][i] = 0.f;
            bf16x8 pf[2][2];
            bf16x8 kfr[10][2];
            float ps = 0.f;
#define KFRAG(t) (*(LAS const bf16x8*)(kn + ((32 * ((t) & 1)) * KSTR + 16 * ((t) >> 1)) * 2))
#define VREAD(g, d, LO, HI) do { LAS const unsigned char* vp_ = vbase + (16 * (g)) * VSTR * 2 + 64 * (d); LO = vtr(vp_); HI = vtr(vp_ + 8 * VSTR * 2); } while (0)
            s16x4 vlo[5][DV / 32], vhi[5][DV / 32];
#pragma unroll
            for (int c0 = 0; c0 < 2; ++c0)
#pragma unroll
                for (int t = c0 * NQK / 8; t < (c0 + 1) * NQK / 8; ++t) kfr[c0][t - c0 * NQK / 8] = KFRAG(t);
            __builtin_amdgcn_sched_barrier(0);
#pragma unroll
            for (int c = 0; c < 8; ++c) {
                if (c + 2 < 8) {
#pragma unroll
                    for (int t = (c + 2) * NQK / 8; t < (c + 3) * NQK / 8; ++t) kfr[c + 2][t - (c + 2) * NQK / 8] = KFRAG(t);
                } else if (c == 6) {
#pragma unroll
                    for (int d = 0; d < DV / 32; ++d) VREAD(0, d, vlo[0][d], vhi[0][d]);
                }
#pragma unroll
                for (int t = c * NQK / 8; t < (c + 1) * NQK / 8; ++t) sn[t & 1] = MFMA32(kfr[c][t - c * NQK / 8], q[t >> 1], sn[t & 1]);
                const int kbc = c >> 2, i0 = 4 * (c & 3);
#pragma unroll
                for (int e = 0; e < 4; ++e) { const float p = AUG ? fexp2(sc[kbc][i0 + e]) : fexp2(sc[kbc][i0 + e] - m); sc[kbc][i0 + e] = p; ps += p; }
                if (c & 1) {
                    const int s8 = 8 * ((c & 3) >> 1);
                    u32x4 w; w.x = pk2(sc[kbc][s8], sc[kbc][s8 + 1]); w.y = pk2(sc[kbc][s8 + 2], sc[kbc][s8 + 3]); w.z = pk2(sc[kbc][s8 + 4], sc[kbc][s8 + 5]); w.w = pk2(sc[kbc][s8 + 6], sc[kbc][s8 + 7]);
                    pf[kbc][(c & 3) >> 1] = __builtin_bit_cast(bf16x8, w);
                }
                __builtin_amdgcn_sched_barrier(0);
            }
            lsum += ps;
#pragma unroll
            for (int g = 0; g < 4; ++g) {
                if (g + 1 < 4) {
#pragma unroll
                    for (int d = 0; d < DV / 32; ++d) VREAD(g + 1, d, vlo[g + 1][d], vhi[g + 1][d]);
                }
#pragma unroll
                for (int d = 0; d < DV / 32; ++d) {
                    const bf16x8 vf = __builtin_shufflevector(vlo[g][d], vhi[g][d], 0, 1, 2, 3, 4, 5, 6, 7);
                    o[d] = MFMA32(vf, pf[g >> 1][g & 1], o[d]);
                }
                __builtin_amdgcn_sched_barrier(0);
            }
#undef KFRAG
#undef VREAD
            sc[0] = sn[0]; sc[1] = sn[1];
        }
        if (!DEEP) { if (half == 0) { ATT_STOREK(0, 0); ATT_STOREV(1, 0); } else { ATT_STOREK(1, 1); ATT_STOREV(0, 1); } }
        __syncthreads();
      }
    }
#undef ATT_LOADK
#undef ATT_LOADV
#undef ATT_STOREK
#undef ATT_STOREV
    const float l = lsum + __shfl_xor(lsum, 32), inv = __builtin_amdgcn_rcpf(l);
#pragma unroll
    for (int d = 0; d < DV / 32; ++d)
#pragma unroll
        for (int i = 0; i < 16; ++i) o[d][i] *= inv;
}

__device__ __forceinline__ bool attn_next(const Ctx& cx, int i, int NU, int NBH, int& bh, int& qb) {
    const int G = cx.G, c = cx.bid;
    if (G == 256) {
        if (i >= NBH / 16) return false;
        const int x = c & 7, ci = c >> 3, g = ci >> 4, k = ci & 15;
        bh = x + 8 * (2 * i + g); qb = (i & 1) ? k : 15 - k; return true;
    }
    const int u = i * G + ((i & 1) ? (G - 1 - c) : c);
    if (u >= NU) return false;
    qb = 15 - u / NBH; bh = u % NBH; return true;
}

__device__ __forceinline__ void attn_diff_phase(const Args& a, const Ctx& cx, LAS unsigned char* lds) {
    unsigned char* ws = cx.ws;
    const int tid = cx.tid, lane = tid & 63, r = lane & 31, h = lane >> 5, wid = tid >> 6;
    const float lambda_init = 0.2f;
    const float lam = __expf(wave_sum(INP(20)[lane] * INP(21)[lane])) - __expf(wave_sum(INP(22)[lane] * INP(23)[lane])) + lambda_init;
    const float* subg = INP(24);
    int bh, qb;
    for (int it = 0; attn_next(cx, it, 512, 32, bh, qb); ++it) {
        const int b = bh >> 3, hd = bh & 7;
        const bf16* Q = (const bf16*)(ws + WS_QK) + (size_t)b * SEQ * 2048 + hd * 128;
        const bf16* K = Q + 1024;
        const bf16* V = (const bf16*)(ws + WS_VA) + (size_t)b * SEQ * 1024 + hd * 128;
        f32x16 o1[4];
        attn_pass<64, 128, false>(cx, lds, Q, 2048, K, 2048, V, 1024, nullptr, nullptr, qb, o1);
        LAS unsigned* park = (LAS unsigned*)(lds + 65536 + wid * 8192) + lane;
#pragma unroll
        for (int d = 0; d < 4; ++d)
#pragma unroll
            for (int i = 0; i < 8; ++i) park[(d * 8 + i) * 64] = pk2(o1[d][2 * i], o1[d][2 * i + 1]);
        attn_pass<64, 128, false>(cx, lds, Q + 64, 2048, K + 64, 2048, V, 1024, nullptr, nullptr, qb, o1);
        float ss = 0.f;
#pragma unroll
        for (int d = 0; d < 4; ++d)
#pragma unroll
            for (int i = 0; i < 8; ++i) {
                const unsigned pw = park[(d * 8 + i) * 64];
                const float a0 = __uint_as_float(pw << 16), a1 = __uint_as_float(pw & 0xffff0000u);
                const float v0 = a0 - lam * o1[d][2 * i], v1 = a1 - lam * o1[d][2 * i + 1];
                o1[d][2 * i] = v0; o1[d][2 * i + 1] = v1; ss += v0 * v0 + v1 * v1;
            }
        ss += __shfl_xor(ss, 32);
        const float rinv = (1.0f - lambda_init) * __builtin_amdgcn_rsqf(ss * (1.0f / 128.0f) + EPS);
        bf16* O = (bf16*)(ws + WS_A) + ((size_t)b * SEQ + qb * 256 + wid * 32 + r) * 2048 + hd * 128;
#pragma unroll
        for (int d = 0; d < 4; ++d)
#pragma unroll
            for (int g = 0; g < 4; ++g) {
                const int dv = 32 * d + 8 * g + 4 * h; const f32x4 sg = *(const f32x4*)(subg + dv);
                u32x2 w; w.x = pk2(o1[d][4 * g] * rinv * sg.x, o1[d][4 * g + 1] * rinv * sg.y); w.y = pk2(o1[d][4 * g + 2] * rinv * sg.z, o1[d][4 * g + 3] * rinv * sg.w);
                *(u32x2*)(O + dv) = w;
            }
    }
}

__device__ __forceinline__ void attn_mla_phase(const Args& a, const Ctx& cx, LAS unsigned char* lds) {
    unsigned char* ws = cx.ws;
    const int tid = cx.tid, lane = tid & 63, r = lane & 31, h = lane >> 5, wid = tid >> 6;
    int bh, qb;
    for (int it = 0; attn_next(cx, it, 512, 32, bh, qb); ++it) {
        const int b = bh >> 3, hd = bh & 7;
        const bf16* Q = (const bf16*)(ws + WS_QB) + (size_t)b * SEQ * 768 + hd * 96;
        const bf16* K = (const bf16*)(ws + WS_KB) + (size_t)b * SEQ * 768 + hd * 96;
        const bf16* V = (const bf16*)(ws + WS_KVB) + (size_t)b * SEQ * 1536 + hd * 192 + 64;
        f32x16 o[4];
        attn_pass<96, 128, false>(cx, lds, Q, 768, K, 768, V, 1536, nullptr, nullptr, qb, o);
        bf16* O = (bf16*)(ws + WS_A) + ((size_t)b * SEQ + qb * 256 + wid * 32 + r) * 2048 + 1024 + hd * 128;
#pragma unroll
        for (int d = 0; d < 4; ++d)
#pragma unroll
            for (int g = 0; g < 4; ++g) { u32x2 w; w.x = pk2(o[d][4 * g], o[d][4 * g + 1]); w.y = pk2(o[d][4 * g + 2], o[d][4 * g + 3]); *(u32x2*)(O + 32 * d + 8 * g + 4 * h) = w; }
    }
}

__device__ __forceinline__ void attn_fox_phase(const Args& a, const Ctx& cx, LAS unsigned char* lds) {
    unsigned char* ws = cx.ws;
    const int tid = cx.tid, lane = tid & 63, r = lane & 31, h = lane >> 5, wid = tid >> 6;
    int bh, qb;
    for (int it = 0; attn_next(cx, it, 1024, 64, bh, qb); ++it) {
        const int b = bh >> 4, hd = bh & 15;
        const bf16* Q = (const bf16*)(ws + WS_QK) + (size_t)b * SEQ * 1024 + hd * 64;
        const bf16* K = (const bf16*)(ws + WS_KH) + (size_t)bh * SEQ * 64;
        const bf16* V = (const bf16*)(ws + WS_VA) + (size_t)bh * SEQ * 64;
        f32x16 o[2];
        attn_pass<64, 64, true>(cx, lds, Q, 1024, K, 64, V, 64, (const bf16*)(ws + WS_QAUG) + (size_t)bh * SEQ * 8, (const bf16*)(ws + WS_KAUG) + (size_t)bh * SEQ * 16, qb, o);
        const size_t ro = ((size_t)b * SEQ + qb * 256 + wid * 32 + r) * 1024 + hd * 64;
        bf16* O = (bf16*)(ws + WS_A) + ro; const bf16* OG = (const bf16*)(ws + WS_OG) + ro;
#pragma unroll
        for (int d = 0; d < 2; ++d)
#pragma unroll
            for (int g = 0; g < 4; ++g) {
                const int dv = 32 * d + 8 * g + 4 * h; const u32x2 gv = *(const u32x2*)(OG + dv);
                const float g0 = __uint_as_float(gv.x << 16), g1 = __uint_as_float(gv.x & 0xffff0000u), g2 = __uint_as_float(gv.y << 16), g3 = __uint_as_float(gv.y & 0xffff0000u);
                u32x2 w; w.x = pk2(o[d][4 * g] * sigmoidf_(g0), o[d][4 * g + 1] * sigmoidf_(g1)); w.y = pk2(o[d][4 * g + 2] * sigmoidf_(g2), o[d][4 * g + 3] * sigmoidf_(g3));
                *(u32x2*)(O + dv) = w;
            }
    }
}

#define XB_TMO      128
#define XB_XCNT(j)  (256  + 64 * (j))
#define XB_XSUB(j)  (1280 + 64 * (j))
#define XB_XGEN(j)  (2304 + 64 * (j))
#define XB_TOP      3328
#define XB_TOPGEN   3392
#define XCD_BAR_WORDS 3456
#define XB_SPIN_CAP (1u << 18)

__device__ __forceinline__ unsigned xb_ld(unsigned* p)              { return __hip_atomic_load(p, __ATOMIC_RELAXED, __HIP_MEMORY_SCOPE_AGENT); }
__device__ __forceinline__ unsigned xb_add(unsigned* p, unsigned v) { return __hip_atomic_fetch_add(p, v, __ATOMIC_RELAXED, __HIP_MEMORY_SCOPE_AGENT); }
__device__ __forceinline__ unsigned xb_xcc_id() { return (unsigned)__builtin_amdgcn_s_getreg((3 << 11) | 20) & 0xFu; }
#define XB_SPIN(cond, bar) do { unsigned _sp = 0; while (cond) { __builtin_amdgcn_s_sleep(1); \
    if ((++_sp & 255u) == 0u) { if (xb_ld(&(bar)[XB_TMO])) break; if (_sp > XB_SPIN_CAP) { atomicAdd(&(bar)[XB_TMO], 1u); break; } } } } while (0)

struct XcdBarrier {
    unsigned* bar; unsigned x;
    volatile LAS unsigned* st;
};

__device__ __forceinline__ XcdBarrier xcd_barrier_post(unsigned* bar, volatile LAS unsigned* st) {
    XcdBarrier b; b.bar = bar; b.x = xb_xcc_id(); b.st = st;
    if (threadIdx.x == 0) (void)xb_add(&bar[XB_XCNT(b.x)], 1u);
    return b;
}
__device__ __forceinline__ void xcd_barrier_complete(unsigned* bar, unsigned x, unsigned& nloc, unsigned& nx) {
    const unsigned G = gridDim.x * gridDim.y * gridDim.z;
    unsigned sum, cnt, mine, sp = 0u;
    for (;;) {
        sum = 0u; cnt = 0u; mine = 0u;
#pragma unroll
        for (unsigned j = 0; j < 16; ++j) { const unsigned c = xb_ld(&bar[XB_XCNT(j)]); sum += c; cnt += (c > 0u) ? 1u : 0u; mine = (j == x) ? c : mine; }
        if (sum == G) break;
        __builtin_amdgcn_s_sleep(1);
        if ((++sp & 255u) == 0u) { if (xb_ld(&bar[XB_TMO])) break; if (sp > XB_SPIN_CAP) { atomicAdd(&bar[XB_TMO], 1u); break; } }
    }
    nloc = mine > 0u ? mine : 1u; nx = cnt > 0u ? cnt : 1u;
}

__device__ __forceinline__ void xcd_barrier(const XcdBarrier& b) {
    asm volatile("s_waitcnt vmcnt(0)" ::: "memory");
    __syncthreads();
    if (threadIdx.x == 0) {
        unsigned* bar = b.bar;
        __builtin_amdgcn_s_waitcnt(0);
        unsigned nloc = b.st[0], nx = b.st[1];
        if (nloc == 0u) { xcd_barrier_complete(bar, b.x, nloc, nx); b.st[0] = nloc; b.st[1] = nx; }
        const unsigned old = xb_add(&bar[XB_XSUB(b.x)], 1u);
        const unsigned gen = old / nloc;
        if (old + 1u == (gen + 1u) * nloc) {
            __builtin_amdgcn_fence(__ATOMIC_RELEASE, "agent");
            asm volatile("s_waitcnt vmcnt(0)" ::: "memory");
            const unsigned og = xb_add(&bar[XB_TOP], 1u);
            const unsigned tg = og / nx;
            if (og + 1u == (tg + 1u) * nx) xb_add(&bar[XB_TOPGEN], 1u);
            else XB_SPIN(xb_ld(&bar[XB_TOPGEN]) == tg, bar);
            __builtin_amdgcn_fence(__ATOMIC_ACQUIRE, "agent");
            xb_add(&bar[XB_XGEN(b.x)], 1u);
            asm volatile("s_waitcnt vmcnt(0)" ::: "memory");
        } else {
            XB_SPIN(xb_ld(&bar[XB_XGEN(b.x)]) == gen, bar);
            __builtin_amdgcn_fence(__ATOMIC_ACQUIRE, "agent");
            asm volatile("s_waitcnt vmcnt(0)" ::: "memory");
        }
    }
    __syncthreads();
}

enum { PH_PROLOGUE = 0, PH_MOD0, PH_GU, PH_DOWN, PH_IN, PH_PREP1E, PH_ATT_DIFF, PH_GEMM_MLA, PH_PREP2E, PH_ATT_MLA, PH_OUT, PH_PREPO, PH_ATT_FOX };
constexpr int NPHASES = 21;
__constant__ const unsigned char PH_TYPE[NPHASES] = {PH_PROLOGUE, PH_MOD0,
    PH_GU, PH_DOWN, PH_IN, PH_PREP1E, PH_ATT_DIFF, PH_GEMM_MLA, PH_PREP2E, PH_ATT_MLA, PH_OUT, PH_GU, PH_DOWN,
    PH_GU, PH_DOWN, PH_IN, PH_PREPO, PH_ATT_FOX, PH_OUT, PH_GU, PH_DOWN};
__constant__ const unsigned char PH_LAYER[NPHASES] = {0, 0, 0, 0, 0, 0, 0, 0, 0, 0, 0, 0, 0, 1, 1, 1, 1, 1, 1, 1, 1};
__constant__ const unsigned char PH_SUB[NPHASES] = {0, 0, 0, 0, 0, 0, 0, 0, 0, 0, 0, 1, 1, 0, 0, 0, 0, 0, 0, 1, 1};

__global__ void __launch_bounds__(NTHR, 2) mk_fwd(Args a) {
    extern __shared__ __attribute__((aligned(16))) unsigned char lds_raw[];
    LAS unsigned char* lds = (LAS unsigned char*)lds_raw;
    cg::grid_group grid = cg::this_grid();
    if (a.ph_lo < 0) grid.sync();
    volatile LAS unsigned* bst = (volatile LAS unsigned*)(lds + LDS_MAIN);
    if (threadIdx.x < 16) bst[threadIdx.x] = 0u;
    __syncthreads();
    const XcdBarrier bar = xcd_barrier_post((unsigned*)(a.ws + WS_CTL), bst);
    const int G = gridDim.x;
    for (int ph = a.ph_lo; ph < a.ph_hi; ++ph) {
        Ctx cx;
        { int zi; asm volatile("s_mov_b32 %0, 0" : "=s"(zi)); cx.zi = zi; }
        { int t_ = threadIdx.x; asm volatile("" : "+v"(t_)); cx.tid = t_; }
        { int b_ = blockIdx.x; asm volatile("" : "+s"(b_)); cx.bid = b_; }
        { int g_ = gridDim.x; asm volatile("" : "+s"(g_)); cx.G = g_; }
        unsigned char* ws = a.ws; asm volatile("" : "+s"(ws)); cx.ws = ws;
        const int G = cx.G;
        float* xbuf = a.out; asm volatile("" : "+s"(xbuf));
        const int type = PH_TYPE[ph], l = PH_LAYER[ph], sub = PH_SUB[ph];
        const float* modl = (const float*)(ws + WS_MOD) + (size_t)l * 4 * NMOD;
        if (type == PH_PROLOGUE) prologue_phase(a, cx, lds);
        else if (type == PH_MOD0) mod0_phase(a, cx);
        else if (type == PH_GU) {
            pg8::Gemm g{(const pg8::bf16_t*)(ws + (sub == 0 ? WS_A : WS_C)), (const pg8::bf16_t*)(ws + WS_WGU) + (size_t)(l * 2 + sub) * 5632 * 1024, T, 2 * FF, DM};
            pg8::StaticOrder S; S.init(T, 2 * FF, G, cx.bid);
            EpiSwiglu E{(bf16*)(ws + WS_ACT), FF, (const float*)(ws + WS_SSQ), (const float*)(ws + WS_BIASV) + (size_t)(l * 2 + sub) * 4 * 5632};
            pg8::gemm_phase<EpiSwiglu, pg8::StaticOrder, PG8_ALIGN, PG8_SP2>(lds, g, S, E, cx.tid);
        } else if (type == PH_DOWN || type == PH_OUT) {
            const bool isdown = type == PH_DOWN;
            const pg8::bf16_t* Ap = (const pg8::bf16_t*)(ws + (isdown ? WS_ACT : WS_A));
            const pg8::bf16_t* Bp = isdown ? (const pg8::bf16_t*)(ws + WS_WD) + (size_t)(l * 2 + sub) * 1024 * 2816 : (const pg8::bf16_t*)(ws + (l == 0 ? WS_WOUT_E : WS_WOUT_O));
            const int Kd = isdown ? FF : (l == 0 ? 2048 : 1024);
            const pg8::Gemm g{Ap, Bp, T, DM, Kd};
            const EpiResid E{ws, INP(0), xbuf, (isdown ? 1 : 0) | (sub << 1) | (l << 2)};
            pg8::StaticOrder S; S.init(T, DM, G, cx.bid);
            pg8::gemm_phase<EpiResid, pg8::StaticOrder, false, PG8_SP2>(lds, g, S, E, cx.tid);
        } else if (type == PH_IN || type == PH_GEMM_MLA) {
            const int nsub = (type == PH_GEMM_MLA) ? 2 : 1;
            for (int si = 0; si < nsub; ++si) {
                pg8::Gemm g; EpiStore E;
                if (type == PH_IN && l == 0) {
                    g = pg8::Gemm{(const pg8::bf16_t*)(ws + WS_A), (const pg8::bf16_t*)(ws + WS_WIN_E), T, 3840, DM};
                    E = EpiStore{(bf16*)(ws + WS_QK), (bf16*)(ws + WS_VA), (bf16*)(ws + WS_LAT), (bf16*)(ws + WS_LAT), 2048, 1024, 768, 768, 8, 12, 1000, -1, nullptr, (const float*)(ws + WS_SSQ), (const float*)(ws + WS_BIASV) + BV_IN_E, 3840, 0};
                } else if (type == PH_IN) {
                    g = pg8::Gemm{(const pg8::bf16_t*)(ws + WS_A), (const pg8::bf16_t*)(ws + WS_WIN_O), T, 4352, DM};
                    E = EpiStore{(bf16*)(ws + WS_QK), (bf16*)(ws + WS_KH), (bf16*)(ws + WS_VA), (bf16*)(ws + WS_OG), 1024, 1024, 1024, 1024, 4, 8, 12, 16, (float*)(ws + WS_FLOG), (const float*)(ws + WS_SSQ), (const float*)(ws + WS_BIASV) + BV_IN_O, 4352, (64 << 8) | (64 << 16)};
                } else if (si == 0) {
                    g = pg8::Gemm{(const pg8::bf16_t*)(ws + WS_CQN), (const pg8::bf16_t*)(ws + WS_WQB), T, 768, 384};
                    E = EpiStore{(bf16*)(ws + WS_QB), (bf16*)(ws + WS_QB), (bf16*)(ws + WS_QB), (bf16*)(ws + WS_QB), 768, 768, 768, 768, 1000, 1000, 1000, -1, nullptr, nullptr, (const float*)(ws + WS_BIASV), 0, 0};
                } else {
                    g = pg8::Gemm{(const pg8::bf16_t*)(ws + WS_CKVN), (const pg8::bf16_t*)(ws + WS_WKVB), T, 1536, 256};
                    E = EpiStore{(bf16*)(ws + WS_KVB), (bf16*)(ws + WS_KVB), (bf16*)(ws + WS_KVB), (bf16*)(ws + WS_KVB), 1536, 1536, 1536, 1536, 1000, 1000, 1000, -1, nullptr, nullptr, (const float*)(ws + WS_BIASV), 0, 0};
                }
                pg8::StaticOrder S; S.init(T, g.N, G, cx.bid);
                pg8::gemm_phase<EpiStore, pg8::StaticOrder, PG8_ALIGN, PG8_SP2>(lds, g, S, E, cx.tid);
                __syncthreads();
            }
        } else if (type == PH_PREP1E) prep1e_phase(a, cx);
        else if (type == PH_PREP2E) prep2e_phase(a, cx);
        else if (type == PH_PREPO) prepo_phase(a, cx, lds);
        else if (type == PH_ATT_DIFF) attn_diff_phase(a, cx, lds);
        else if (type == PH_ATT_MLA) attn_mla_phase(a, cx, lds);
        else if (type == PH_ATT_FOX) attn_fox_phase(a, cx, lds);
        if (ph + 1 < a.ph_hi) xcd_barrier(bar);
    }
}

extern "C" void kernel_launch(void* const* d_in, const int* in_sizes, int n_in, void* d_out, int out_size, void* d_ws, size_t ws_size, hipStream_t stream) {
    static int grid = 0;
    if (grid == 0) {
        if (n_in != 31 || out_size != T * DM || ws_size < WS_END) { fprintf(stderr, "kernel_launch: unexpected problem: n_in %d out %d ws %zu (need %zu)\n", n_in, out_size, ws_size, (size_t)WS_END); grid = -1; return; }
        int dev = 0, cus = 0, per_cu = 0;
        (void)hipGetDevice(&dev);
        (void)hipDeviceGetAttribute(&cus, hipDeviceAttributeMultiprocessorCount, dev);
        if (hipFuncSetAttribute((const void*)mk_fwd, hipFuncAttributeMaxDynamicSharedMemorySize, LDS_BYTES) != hipSuccess) fprintf(stderr, "kernel_launch: hipFuncSetAttribute failed\n");
        if (hipOccupancyMaxActiveBlocksPerMultiprocessor(&per_cu, (const void*)mk_fwd, NTHR, LDS_BYTES) != hipSuccess || per_cu < 1) { fprintf(stderr, "kernel_launch: occupancy query says %d\n", per_cu); per_cu = 1; }
        (void)hipGetLastError();
        if (cus <= 0) cus = 256;
        grid = cus * (per_cu > 1 ? 1 : per_cu);
    }
    if (grid < 0) return;
    Args a{};
    for (int i = 0; i < 31; ++i) a.in[i] = (const float*)d_in[i];
    a.out = (float*)d_out; a.ws = (unsigned char*)d_ws;
    if (hipMemsetAsync((char*)d_ws + WS_CTL, 0, CTL_ZERO_BYTES, stream) != hipSuccess) { fprintf(stderr, "kernel_launch: hipMemsetAsync failed\n"); return; }
    a.ph_lo = 0; a.ph_hi = NPHASES;
    void* args[] = {&a};
    hipError_t e = hipLaunchCooperativeKernel((const void*)mk_fwd, dim3(grid), dim3(NTHR), args, LDS_BYTES, stream);
    if (e != hipSuccess) fprintf(stderr, "kernel_launch: cooperative launch failed: %s (grid %d)\n", hipGetErrorString(e), grid);
}
```

```cpp
#include <hip/hip_runtime.h>
#include <hip/hip_cooperative_groups.h>
#include <cstdio>
#include <cstdint>
namespace cg = cooperative_groups;
namespace pg8 {
#define PG8_LAS __attribute__((address_space(3)))
typedef unsigned short bf16_t;
typedef short bf16x8 __attribute__((ext_vector_type(8)));
typedef float f32x4 __attribute__((ext_vector_type(4)));
typedef unsigned u32x4 __attribute__((ext_vector_type(4)));
constexpr int BM = 256, BK = 64, HALF = 128, HTB = HALF * BK * 2  , STAGE_BYTES = 8 * HTB, NXCD = 8, WGM = 8;

__host__ __device__ __forceinline__ int lds_byte(int r, int c) { const int st = (r >> 4) * 2 + (c >> 5), rr = r & 15, cc = c & 31, ob = rr * 64 + cc * 2; return st * 1024 + (ob ^ (((ob >> 9) & 1) << 5)); }
__host__ __device__ __forceinline__ void stage_rc(int b, int& R, int& C) { const int st = b / 1024, sb = b % 1024, swz = sb ^ (((sb >> 9) & 1) << 5); R = (st >> 1) * 16 + swz / 64; C = (st & 1) * 32 + (swz % 64) / 2; }
__host__ __device__ __forceinline__ int perm32(int rho) { const int n = rho >> 4, i = rho & 15; return 8 * (i >> 2) + 4 * n + (i & 3); }

struct Unit { int pm, pn; };
struct Gemm { const bf16_t* A; const bf16_t* Bt; int M, N, K; };

struct StaticOrder {
    int nM, nN, nwg, G, c;
    __host__ __device__ void init(int M, int N, int G_, int c_) { nM = M / BM; nN = N / BM; nwg = nM * nN; G = G_; c = c_; }
    __host__ __device__ bool next(int i, Unit& u) const {
        const long L = (long)i * G + c; if (L >= nwg) return false;
        int wgid = (int)L; { const int q = nwg / NXCD, r = nwg % NXCD, xcd = wgid % NXCD, off = wgid / NXCD; wgid = (xcd < r ? xcd * (q + 1) : r * (q + 1) + (xcd - r) * q) + off; }
        const int nig = WGM * nN, gid = wgid / nig, fm = gid * WGM, gsz = (nM - fm) < WGM ? (nM - fm) : WGM;
        u.pm = fm + ((wgid % nig) % gsz); u.pn = (wgid % nig) / gsz; return true;
    }
    __device__ __forceinline__ void a_ready(const Unit&) const {}
    __device__ __forceinline__ void done(const Unit&) const {}
};

__device__ __forceinline__ unsigned cvt_pk_bf16(float lo, float hi) { unsigned r; asm volatile("v_cvt_pk_bf16_f32 %0, %1, %2" : "=v"(r) : "v"(lo), "v"(hi)); return r; }
typedef float f32x2 __attribute__((ext_vector_type(2)));
template <class Epi, class Sched, bool ALIGN_EPI = false, bool SP2 = false>
__device__ __forceinline__ void gemm_phase(PG8_LAS unsigned char* lds, const Gemm g, const Sched& S, const Epi& E, const int tid_in) {
    const int tid = tid_in, wid = __builtin_amdgcn_readfirstlane(tid >> 6), lane = tid & 63, wr = wid >> 2, wc = wid & 3, fr = lane & 15, fq = lane >> 4;
    const int K = g.K, nt = K / BK;
    unsigned voffA[2], voffB[2];
#pragma unroll
    for (int i = 0; i < 2; ++i) { int R, C; stage_rc(tid * 16 + i * 8192, R, C); const int Rb = Epi::PERM ? ((R & ~31) + perm32(R & 31)) : R;
        voffA[i] = (unsigned)(R * K + C) * 2u; voffB[i] = (unsigned)(Rb * K + C) * 2u; }
    const size_t kstep = (size_t)(BK * 2);
    const size_t hstep = (size_t)HALF * K * 2;
    const size_t tstep = 2 * hstep;
    const unsigned ldsw = (unsigned)wid * 1024u;
    const int aoff = lds_byte(wr * 64 + fr, fq * 8), boff = lds_byte(wc * 32 + fr, fq * 8);
#define PG8_SA(b, h) (((b) * 2 + (h)) * HTB)
#define PG8_SB(b, h) ((4 + (b) * 2 + (h)) * HTB)
#define PG8_STAGE(bufoff, gbase, voff) do { _Pragma("unroll") for (int _i = 0; _i < 2; ++_i) \
        __builtin_amdgcn_global_load_lds((const unsigned*)((const char*)(gbase) + (voff)[_i]), (PG8_LAS unsigned*)(lds + (bufoff) + ldsw + _i * 8192), 16, 0, 0); } while (0)
#define PG8_LDA(dst, b, h) do { _Pragma("unroll") for (int m = 0; m < 4; ++m) _Pragma("unroll") for (int k = 0; k < 2; ++k) dst[m][k] = *(const PG8_LAS bf16x8*)(lds + PG8_SA(b, h) + aoff + m * 2048 + k * 1024); } while (0)
#define PG8_LDB(dst, b, h) do { _Pragma("unroll") for (int n = 0; n < 2; ++n) _Pragma("unroll") for (int k = 0; k < 2; ++k) dst[n][k] = *(const PG8_LAS bf16x8*)(lds + PG8_SB(b, h) + boff + n * 2048 + k * 1024); } while (0)
#define PG8_MMA(ai, bj, At, Bt) do { __builtin_amdgcn_s_setprio(1); _Pragma("unroll") for (int m = 0; m < 4; ++m) _Pragma("unroll") for (int n = 0; n < 2; ++n) _Pragma("unroll") for (int k = 0; k < 2; ++k) \
        acc[ai][bj][m][n] = __builtin_amdgcn_mfma_f32_16x16x32_bf16(Bt[n][k], At[m][k], acc[ai][bj][m][n], 0, 0, 0); __builtin_amdgcn_s_setprio(0); } while (0)
#define PG8_WAIT_V(n) asm volatile("s_waitcnt vmcnt(" #n ")" ::: "memory")
#define PG8_WAIT_L(n) asm volatile("s_waitcnt lgkmcnt(" #n ")" ::: "memory")
#define PG8_BAR __builtin_amdgcn_s_barrier()
#define PG8_SCHED __builtin_amdgcn_sched_barrier(0)
    Unit cur, nxt; int ui = 0;
    if (!S.next(0, cur)) return;
    f32x4 acc[2][2][4][2];
#pragma unroll
    for (int a = 0; a < 2; ++a)
#pragma unroll
        for (int b = 0; b < 2; ++b)
#pragma unroll
            for (int m = 0; m < 4; ++m)
#pragma unroll
                for (int n = 0; n < 2; ++n) acc[a][b][m][n] = (f32x4){0.f, 0.f, 0.f, 0.f};
    bf16x8 At[4][2], B0[2][2], B1[2][2];
    const char* cA = (const char*)g.A + (size_t)cur.pm * tstep; const char* cB = (const char*)g.Bt + (size_t)cur.pn * tstep;
    S.a_ready(cur);
    if constexpr (SP2) {
        PG8_STAGE(PG8_SB(0, 0), cB, voffB); PG8_STAGE(PG8_SB(0, 1), cB + hstep, voffB); PG8_STAGE(PG8_SA(0, 0), cA, voffA); PG8_STAGE(PG8_SA(0, 1), cA + hstep, voffA);
        if (wr == 1) PG8_BAR;
        PG8_WAIT_V(2); PG8_BAR;
        PG8_STAGE(PG8_SB(1, 0), cB + kstep, voffB); PG8_STAGE(PG8_SA(1, 0), cA + kstep, voffA); PG8_STAGE(PG8_SB(1, 1), cB + hstep + kstep, voffB);
        PG8_WAIT_V(6); PG8_BAR;
    } else {
        PG8_STAGE(PG8_SB(0, 0), cB, voffB); PG8_STAGE(PG8_SA(0, 0), cA, voffA); PG8_STAGE(PG8_SB(0, 1), cB + hstep, voffB); PG8_STAGE(PG8_SA(0, 1), cA + hstep, voffA);
        if (wr == 1) PG8_BAR;
        PG8_WAIT_V(4); PG8_BAR;
        PG8_STAGE(PG8_SB(1, 0), cB + kstep, voffB); PG8_STAGE(PG8_SA(1, 0), cA + kstep, voffA); PG8_STAGE(PG8_SB(1, 1), cB + hstep + kstep, voffB);
        PG8_WAIT_V(6); PG8_BAR;
    }
    for (;;) {
        const bool has_next = S.next(ui + 1, nxt);
        const char* nA = has_next ? (const char*)g.A + (size_t)nxt.pm * tstep : cA; const char* nB = has_next ? (const char*)g.Bt + (size_t)nxt.pn * tstep : cB;
        for (int t = 0; t < nt; t += 2) {
            const bool last = (t == nt - 2);
            const char* a1 = cA + (size_t)(t + 1) * kstep;
            const char* a2 = last ? nA : cA + (size_t)(t + 2) * kstep; const char* b2 = last ? nB : cB + (size_t)(t + 2) * kstep;
            const char* a3 = a2 + kstep; const char* b3 = b2 + kstep;
            if (last && has_next) S.a_ready(nxt);
            if constexpr (SP2) {
            PG8_LDB(B0, 0, 0); PG8_LDB(B1, 0, 1); PG8_SCHED; PG8_LDA(At, 0, 0); PG8_STAGE(PG8_SA(1, 1), a1 + hstep, voffA);
            PG8_WAIT_V(8); PG8_WAIT_L(0); PG8_BAR; PG8_MMA(0, 0, At, B0); PG8_MMA(0, 1, At, B1); PG8_BAR; PG8_SCHED;
            PG8_LDA(At, 0, 1); PG8_STAGE(PG8_SB(0, 0), b2, voffB); PG8_STAGE(PG8_SB(0, 1), b2 + hstep, voffB); PG8_STAGE(PG8_SA(0, 0), a2, voffA);
            PG8_WAIT_V(8); PG8_WAIT_L(0); PG8_BAR; PG8_MMA(1, 0, At, B0); PG8_MMA(1, 1, At, B1); PG8_BAR; PG8_SCHED;
            PG8_LDB(B0, 1, 0); PG8_LDB(B1, 1, 1); PG8_SCHED; PG8_LDA(At, 1, 0); PG8_STAGE(PG8_SA(0, 1), a2 + hstep, voffA);
            PG8_WAIT_V(8); PG8_WAIT_L(0); PG8_BAR; PG8_MMA(0, 0, At, B0); PG8_MMA(0, 1, At, B1); PG8_BAR; PG8_SCHED;
            PG8_LDA(At, 1, 1); PG8_STAGE(PG8_SB(1, 0), b3, voffB); PG8_STAGE(PG8_SB(1, 1), b3 + hstep, voffB); PG8_STAGE(PG8_SA(1, 0), a3, voffA);
            PG8_WAIT_V(8); PG8_WAIT_L(0); PG8_BAR; PG8_MMA(1, 0, At, B0); PG8_MMA(1, 1, At, B1); PG8_BAR; PG8_SCHED;
            } else {
            PG8_LDB(B0, 0, 0); PG8_SCHED; PG8_LDA(At, 0, 0); PG8_STAGE(PG8_SA(1, 1), a1 + hstep, voffA);
            PG8_WAIT_L(8); PG8_BAR; PG8_WAIT_L(0); PG8_MMA(0, 0, At, B0); PG8_BAR; PG8_SCHED;
            PG8_LDB(B1, 0, 1); PG8_STAGE(PG8_SB(0, 0), b2, voffB);
            PG8_BAR; PG8_WAIT_L(0); PG8_MMA(0, 1, At, B1); PG8_BAR;
            PG8_LDA(At, 0, 1); PG8_STAGE(PG8_SA(0, 0), a2, voffA);
            PG8_BAR; PG8_WAIT_L(0); PG8_MMA(1, 0, At, B0); PG8_BAR; PG8_SCHED;
            PG8_STAGE(PG8_SB(0, 1), b2 + hstep, voffB);
            PG8_WAIT_V(6); PG8_BAR; PG8_MMA(1, 1, At, B1); PG8_BAR;
            PG8_LDB(B0, 1, 0); PG8_SCHED; PG8_LDA(At, 1, 0); PG8_STAGE(PG8_SA(0, 1), a2 + hstep, voffA);
            PG8_WAIT_L(8); PG8_BAR; PG8_WAIT_L(0); PG8_MMA(0, 0, At, B0); PG8_BAR; PG8_SCHED;
            PG8_LDB(B1, 1, 1); PG8_STAGE(PG8_SB(1, 0), b3, voffB);
            PG8_BAR; PG8_WAIT_L(0); PG8_MMA(0, 1, At, B1); PG8_BAR;
            PG8_LDA(At, 1, 1); PG8_STAGE(PG8_SA(1, 0), a3, voffA);
            PG8_BAR; PG8_WAIT_L(0); PG8_MMA(1, 0, At, B0); PG8_BAR; PG8_SCHED;
            PG8_STAGE(PG8_SB(1, 1), b3 + hstep, voffB);
            PG8_WAIT_V(6); PG8_BAR; PG8_MMA(1, 1, At, B1); PG8_BAR;
            }
        }
        if constexpr (ALIGN_EPI) { if (wr == 0) PG8_BAR; }
        if constexpr (!Epi::AFTER_DRAIN) { E(acc, cur, wr, wc, fr, fq); S.done(cur); }
        if (!has_next) break;
#pragma unroll
        for (int a = 0; a < 2; ++a)
#pragma unroll
            for (int b = 0; b < 2; ++b)
#pragma unroll
                for (int m = 0; m < 4; ++m)
#pragma unroll
                    for (int n = 0; n < 2; ++n) acc[a][b][m][n] = (f32x4){0.f, 0.f, 0.f, 0.f};
        cur = nxt; cA = nA; cB = nB; ++ui;
        if constexpr (ALIGN_EPI) { if (wr == 1) PG8_BAR; }
    }
    PG8_WAIT_V(0);
    if constexpr (!ALIGN_EPI) { if (wr == 0) PG8_BAR; }
    PG8_BAR;
    if constexpr (Epi::AFTER_DRAIN) { E.fused(acc, cur, wr, wc, fr, fq, lds, wid, lane); S.done(cur); }
#undef PG8_SA
#undef PG8_SB
#undef PG8_STAGE
#undef PG8_LDA
#undef PG8_LDB
#undef PG8_MMA
#undef PG8_WAIT_V
#undef PG8_WAIT_L
#undef PG8_BAR
#undef PG8_SCHED
}
}
#ifndef PG8_SP2
#define PG8_SP2 true
#endif
#ifndef PG8_ALIGN
#define PG8_ALIGN true
#endif
constexpr int NB = 4, SEQ = 4096, T = NB * SEQ, DM = 1024, FF = 2816, NMOD = 9 * DM;
constexpr float EPS = 1e-6f;
constexpr float LOG2E = 1.4426950408889634f;
constexpr int NWAVES = 8, NTHR = 512;
constexpr int LDS_MAIN = 131072;
constexpr int LDS_BYTES = LDS_MAIN + 64;

#define LAS __attribute__((address_space(3)))
#define GAS __attribute__((address_space(1)))
typedef unsigned short bf16;
typedef short bf16x8 __attribute__((ext_vector_type(8)));
typedef short s16x4 __attribute__((ext_vector_type(4)));
typedef float f32x2 __attribute__((ext_vector_type(2)));
typedef float f32x4 __attribute__((ext_vector_type(4)));
typedef float f32x16 __attribute__((ext_vector_type(16)));
typedef unsigned u32x2 __attribute__((ext_vector_type(2)));
typedef unsigned u32x4 __attribute__((ext_vector_type(4)));
typedef __bf16 bf16x2_t __attribute__((ext_vector_type(2)));

constexpr size_t MiB = 1u << 20;
constexpr size_t WS_CTL = 0, CTL_ZERO_BYTES = 16384;
constexpr size_t WS_SSQ = 64 * 1024;
constexpr size_t WS_WGU = 1 * MiB;
constexpr size_t WS_WD = 45 * MiB;
constexpr size_t WS_WIN_E = 67 * MiB;
constexpr size_t WS_WQB = WS_WIN_E + 7680 * 1024;
constexpr size_t WS_WKVB = WS_WQB + 768 * 1024;
constexpr size_t WS_WOUT_E = 76 * MiB;
constexpr size_t WS_WIN_O = 80 * MiB;
constexpr size_t WS_WOUT_O = WS_WIN_O + 8704 * 1024;
constexpr size_t WS_MOD = 91 * MiB;
constexpr size_t WS_BIASV = WS_MOD + 512 * 1024;
constexpr int BV_IN_E = 4 * 4 * 5632, BV_IN_O = BV_IN_E + 4 * 3840;
constexpr size_t WS_CUM = 92 * MiB;
constexpr size_t WS_FLOG = 93 * MiB;
constexpr size_t WS_A = 94 * MiB;
constexpr size_t WS_C = 158 * MiB;
constexpr size_t WS_LAT = WS_C, WS_CQN = WS_C + 24 * MiB, WS_CKVN = WS_C + 36 * MiB, WS_OG = WS_C;
constexpr size_t WS_QAUG = WS_C + 32 * MiB, WS_KAUG = WS_C + 36 * MiB;
constexpr size_t WS_B = 202 * MiB;
constexpr size_t WS_KH = WS_B + 32 * MiB;
constexpr size_t WS_ACT = WS_B, WS_QK = WS_B, WS_VA = WS_B + 64 * MiB, WS_QB = WS_B, WS_KVB = WS_B + 24 * MiB, WS_KB = WS_B + 72 * MiB;
constexpr size_t WS_END = 298 * MiB;

__device__ __forceinline__ float bf2f(bf16 v) { return __uint_as_float((unsigned)v << 16); }
__device__ __forceinline__ unsigned pk2(float lo, float hi) { f32x2 v = {lo, hi}; bf16x2_t b = __builtin_convertvector(v, bf16x2_t); return __builtin_bit_cast(unsigned, b); }
__device__ __forceinline__ bf16 f2bf(float f) { return (bf16)(pk2(f, 0.f) & 0xffffu); }
__device__ __forceinline__ float wave_sum(float v) {
#pragma unroll
    for (int o = 1; o < 64; o <<= 1) v += __shfl_xor(v, o);
    return v;
}
__device__ __forceinline__ float half_sum(float v) {
#pragma unroll
    for (int o = 1; o < 32; o <<= 1) v += __shfl_xor(v, o);
    return v;
}
__device__ __forceinline__ float fexp2(float x) { return __builtin_amdgcn_exp2f(x); }
__device__ __forceinline__ float sigmoidf_(float x) { return __builtin_amdgcn_rcpf(1.0f + fexp2(-x * LOG2E)); }
__device__ __forceinline__ int crow(int i, int h) { return (i & 3) + 8 * (i >> 2) + 4 * h; }
#define LDS_WAIT() asm volatile("s_waitcnt lgkmcnt(0)" ::: "memory")
__device__ __forceinline__ float bf16r(float x) { return __uint_as_float(pk2(x, 0.f) << 16); }
__device__ __forceinline__ void split3(float x, float& hi, float& mid, float& lo) { hi = bf16r(x); const float r1 = x - hi; mid = bf16r(r1); lo = bf16r(r1 - mid); }
__device__ __forceinline__ bf16x8 split3frag(float x) { float a, b, c; split3(x, a, b, c); u32x4 w; w.x = pk2(a, b); w.y = pk2(c, 0.f); w.z = 0u; w.w = 0u; return __builtin_bit_cast(bf16x8, w); }

__device__ __forceinline__ float row_rinv(const float* __restrict__ ssq, int row) {
    const f32x4 q = *(const f32x4*)(ssq + (size_t)row * 4);
    return __builtin_amdgcn_rsqf(((q.x + q.y) + (q.z + q.w)) * (1.0f / DM) + EPS);
}
struct EpiSwiglu {
    static constexpr bool PERM = true, AFTER_DRAIN = false;
    bf16* O; int ldc; const float* ssq; const float* bias;
    __device__ __forceinline__ void operator()(const pg8::f32x4 (&acc)[2][2][4][2], const pg8::Unit& u, int wr, int wc, int fr, int fq) const {
        const int row0 = u.pm * 256 + wr * 64 + fr, col0 = u.pn * 128 + wc * 32 + 8 * fq;
        const float* bp = bias + (size_t)(u.pm >> 4) * 5632 + u.pn * 256 + wc * 32 + 8 * fq;
        const f32x4 bg0 = *(const f32x4*)bp, bg1 = *(const f32x4*)(bp + 4), bu0 = *(const f32x4*)(bp + 128), bu1 = *(const f32x4*)(bp + 132);
#pragma unroll
        for (int ai = 0; ai < 2; ++ai)
#pragma unroll
            for (int m = 0; m < 4; ++m) {
                const int row = row0 + ai * 128 + m * 16;
                const float rinv = row_rinv(ssq, row);
                bf16* rowp = O + (size_t)row * ldc + col0;
                float v[8];
#pragma unroll
                for (int n = 0; n < 2; ++n)
#pragma unroll
                    for (int e = 0; e < 4; ++e) {
                        const float g = acc[ai][0][m][n][e] * rinv + (n == 0 ? bg0[e] : bg1[e]), up = acc[ai][1][m][n][e] * rinv + (n == 0 ? bu0[e] : bu1[e]);
                        v[4 * n + e] = g * sigmoidf_(g) * up;
                    }
                u32x4 w; w.x = pk2(v[0], v[1]); w.y = pk2(v[2], v[3]); w.z = pk2(v[4], v[5]); w.w = pk2(v[6], v[7]);
                *(u32x4*)rowp = w;
            }
    }
};
struct EpiResid {
    static constexpr bool PERM = false, AFTER_DRAIN = true;
    unsigned char* ws; const float* x0; float* xbuf; int code;
    __device__ __forceinline__ void fused(pg8::f32x4 (&acc)[2][2][4][2], const pg8::Unit& u, int wr, int wc, int fr, int fq, LAS unsigned char* lds, int wid, int lane) const {
        const bool isdown = code & 1; const int sub = (code >> 1) & 1, l = code >> 2;
        const float* modl = (const float*)(ws + WS_MOD) + (size_t)l * 4 * NMOD;
        const float* scn = !isdown ? modl + 7 * DM : (sub == 0 ? modl + 4 * DM : (l == 0 ? modl + 4 * NMOD + 1 * DM : nullptr));
        const float* xin = (isdown && l == 0 && sub == 0) ? x0 : xbuf; float* xout = xbuf;
        const float* g = modl + (isdown ? (sub == 0 ? 2 : 8) : 5) * DM;
        const float coef = isdown ? 0.5f : 1.0f;
        bf16* xt = (bf16*)(ws + (isdown ? WS_A : WS_C)); float* ssq = (float*)(ws + WS_SSQ);
        const int b = u.pm >> 4, col0 = u.pn * 256 + wc * 32 + 4 * fq;
        const bool nxt = scn != nullptr;
        f32x4 gv[2][2], sv[2][2];
#pragma unroll
        for (int bj = 0; bj < 2; ++bj)
#pragma unroll
            for (int n = 0; n < 2; ++n) {
                gv[bj][n] = *(const f32x4*)(g + (size_t)b * NMOD + col0 + bj * 128 + n * 16) * coef;
                sv[bj][n] = nxt ? (*(const f32x4*)(scn + (size_t)b * NMOD + col0 + bj * 128 + n * 16) + 1.0f) : (f32x4){0.f, 0.f, 0.f, 0.f};
            }
        LAS float* P = (LAS float*)lds;
#pragma unroll
        for (int ai = 0; ai < 2; ++ai) {
            f32x4 xi[4][2][2];
#pragma unroll
            for (int m = 0; m < 4; ++m) {
                const size_t off = (size_t)(u.pm * 256 + ai * 128 + wr * 64 + m * 16 + fr) * DM + col0;
#pragma unroll
                for (int bj = 0; bj < 2; ++bj)
#pragma unroll
                    for (int n = 0; n < 2; ++n) xi[m][bj][n] = *(const f32x4*)(xin + off + bj * 128 + n * 16);
            }
            asm volatile("" ::: "memory");
#pragma unroll
            for (int m = 0; m < 4; ++m) {
                const int rl = ai * 128 + wr * 64 + m * 16 + fr;
                const size_t off = (size_t)(u.pm * 256 + rl) * DM + col0;
                float s = 0.f;
#pragma unroll
                for (int bj = 0; bj < 2; ++bj)
#pragma unroll
                    for (int n = 0; n < 2; ++n) {
                        const f32x4 xn = xi[m][bj][n] + gv[bj][n] * acc[ai][bj][m][n];
                        *(f32x4*)(xout + off + bj * 128 + n * 16) = xn;
                        if (nxt) {
                            s += (xn.x * xn.x + xn.y * xn.y) + (xn.z * xn.z + xn.w * xn.w);
                            const f32x4 y = xn * sv[bj][n];
                            u32x2 w; w.x = pk2(y.x, y.y); w.y = pk2(y.z, y.w);
                            *(u32x2*)(xt + off + bj * 128 + n * 16) = w;
                        }
                    }
                if (nxt) { s += __shfl_xor(s, 16); s += __shfl_xor(s, 32); if (fq == 0) P[rl * 4 + wc] = s; }
            }
        }
        if (nxt) {
            __syncthreads();
            const int t = wid * 64 + lane;
            if (t < 256) { const f32x4 p = *(LAS const f32x4*)(P + t * 4); ssq[(size_t)(u.pm * 256 + t) * 4 + u.pn] = (p.x + p.y) + (p.z + p.w); }
        }
    }
};
struct EpiStore {
    static constexpr bool PERM = true, AFTER_DRAIN = false;
    bf16 *b0, *b1, *b2, *b3; int l0, l1, l2, l3, t1, t2, t3, ft; float* fb; const float* ssq; const float* bias; int bn;
    int hm;
    __device__ __forceinline__ void operator()(const pg8::f32x4 (&acc)[2][2][4][2], const pg8::Unit& u, int wr, int wc, int fr, int fq) const {
        const int pn = u.pn, row0 = u.pm * 256 + wr * 64 + fr;
        const bool modn = ssq != nullptr;
        const float* bp = bias + (size_t)(u.pm >> 4) * bn + pn * 256 + wc * 32 + 8 * fq;
        pg8::f32x4 bv[2][2];
#pragma unroll
        for (int bj = 0; bj < 2; ++bj)
#pragma unroll
            for (int n = 0; n < 2; ++n) bv[bj][n] = modn ? *(const pg8::f32x4*)(bp + bj * 128 + 4 * n) : (pg8::f32x4){0.f, 0.f, 0.f, 0.f};
        if (pn == ft) {
            if (wc == 0 && fq < 2) {
#pragma unroll
                for (int ai = 0; ai < 2; ++ai)
#pragma unroll
                    for (int m = 0; m < 4; ++m) {
                        const int row = row0 + ai * 128 + m * 16; const float rinv = modn ? row_rinv(ssq, row) : 1.0f;
#pragma unroll
                        for (int n = 0; n < 2; ++n) *(pg8::f32x4*)(fb + (size_t)row * 16 + 8 * fq + 4 * n) = acc[ai][0][m][n] * rinv + bv[0][n];
                    }
            }
            return;
        }
        bf16* base; int ldc, ts, hd;
        if (pn < t1) { base = b0; ldc = l0; ts = 0; hd = hm & 255; } else if (pn < t2) { base = b1; ldc = l1; ts = t1; hd = (hm >> 8) & 255; } else if (pn < t3) { base = b2; ldc = l2; ts = t2; hd = (hm >> 16) & 255; } else { base = b3; ldc = l3; ts = t3; hd = (hm >> 24) & 255; }
        const int col0 = (pn - ts) * 256 + wc * 32 + 8 * fq;
        size_t coff[2];
#pragma unroll
        for (int bj = 0; bj < 2; ++bj) { const int c = col0 + bj * 128; if (hd == 0) coff[bj] = (size_t)c; else { const int head = c / hd; coff[bj] = (size_t)head * SEQ * hd + (c - head * hd); } }
#pragma unroll
        for (int ai = 0; ai < 2; ++ai)
#pragma unroll
            for (int m = 0; m < 4; ++m) {
                const int row = row0 + ai * 128 + m * 16; const float rinv = modn ? row_rinv(ssq, row) : 1.0f;
                bf16* rowp = base + (hd == 0 ? (size_t)row * ldc : (size_t)(row >> 12) * SEQ * ldc + (size_t)(row & (SEQ - 1)) * hd);
#pragma unroll
                for (int bj = 0; bj < 2; ++bj) {
                    const pg8::f32x4 v0 = acc[ai][bj][m][0] * rinv + bv[bj][0], v1 = acc[ai][bj][m][1] * rinv + bv[bj][1];
                    u32x4 w; w.x = pk2(v0[0], v0[1]); w.y = pk2(v0[2], v0[3]); w.z = pk2(v1[0], v1[1]); w.w = pk2(v1[2], v1[3]);
                    *(u32x4*)(rowp + coff[bj]) = w;
                }
            }
    }
};

__device__ __forceinline__ void transpose_item(const float* __restrict__ W, int K, int ldw, int nblk, bf16* __restrict__ WT, int mode, LAS float* scr, int item, int lane) {
    const int kb = item / nblk, nb = item - kb * nblk, k0 = 64 * kb, n0 = 32 * nb;
#pragma unroll 8
    for (int i = 0; i < 32; ++i) { const int kk = 2 * i + (lane >> 5); scr[kk * 33 + (lane & 31)] = __builtin_nontemporal_load(W + (size_t)(k0 + kk) * ldw + n0 + (lane & 31)); }
    LDS_WAIT();
    const int c = lane & 7;
#pragma unroll
    for (int j = 0; j < 4; ++j) {
        const int n = (lane >> 3) + 8 * j, gn = n0 + n;
        const int row = mode == 0 ? gn : ((gn >> 7) * 256 + (gn & 127) + (mode == 2 ? 128 : 0));
        const LAS float* s = scr + (8 * c) * 33 + n;
        u32x4 o; o.x = pk2(s[0 * 33], s[1 * 33]); o.y = pk2(s[2 * 33], s[3 * 33]); o.z = pk2(s[4 * 33], s[5 * 33]); o.w = pk2(s[6 * 33], s[7 * 33]);
        *(u32x4*)(WT + (size_t)row * K + k0 + 8 * c) = o;
    }
    LDS_WAIT();
}

struct Args { const float* in[31]; float* out; unsigned char* ws; int ph_lo, ph_hi; };
struct Ctx { int tid, bid, G, zi; unsigned char* ws; };
#define INP(k) (a.in[(k) + cx.zi])

__device__ __forceinline__ void prologue_phase(const Args& a, const Ctx& cx, LAS unsigned char* lds) {
    unsigned char* ws = cx.ws;
    const int tid = cx.tid, lane = tid & 63, wave = tid >> 6, G = cx.G;
    const int gw = cx.bid * NWAVES + wave, NGW = G * NWAVES;
    LAS float* scr = (LAS float*)(lds + wave * 8704);
    constexpr int I_FF = 1408, N_FF = 12 * I_FF;
    constexpr int I_INE = 16 * 117, I_QB = 6 * 24, I_KVB = 4 * 48, I_OUTE = 32 * 32, I_INO = 16 * 128, I_OUTO = 16 * 32;
    constexpr int NITEMS = N_FF + I_INE + I_QB + I_KVB + I_OUTE + I_INO + I_OUTO;
    for (int it = gw; it < NITEMS; it += NGW) {
        int r = it;
        if (r < N_FF) {
            const int id = r / I_FF, item = r - id * I_FF, lf = id / 3, which = id - lf * 3, l = lf >> 1, f = lf & 1;
            if (which < 2) transpose_item(INP(5 + f * 3 + which) + (size_t)l * DM * FF, DM, FF, FF / 32, (bf16*)(ws + WS_WGU) + (size_t)lf * 5632 * 1024, 1 + which, scr, item, lane);
            else transpose_item(INP(7 + f * 3) + (size_t)l * FF * DM, FF, DM, DM / 32, (bf16*)(ws + WS_WD) + (size_t)lf * 1024 * 2816, 0, scr, item, lane);
            continue;
        }
        r -= N_FF;
        if (r < I_INE) { transpose_item(INP(11), 1024, 3744, 117, (bf16*)(ws + WS_WIN_E), 0, scr, r, lane); continue; } r -= I_INE;
        if (r < I_QB) { transpose_item(INP(12), 384, 768, 24, (bf16*)(ws + WS_WQB), 0, scr, r, lane); continue; } r -= I_QB;
        if (r < I_KVB) { transpose_item(INP(13), 256, 1536, 48, (bf16*)(ws + WS_WKVB), 0, scr, r, lane); continue; } r -= I_KVB;
        if (r < I_OUTE) { transpose_item(INP(25), 2048, 1024, 32, (bf16*)(ws + WS_WOUT_E), 0, scr, r, lane); continue; } r -= I_OUTE;
        if (r < I_INO) { transpose_item(INP(26), 1024, 4112, 128, (bf16*)(ws + WS_WIN_O), 0, scr, r, lane); continue; } r -= I_INO;
        transpose_item(INP(30), 1024, 1024, 32, (bf16*)(ws + WS_WOUT_O), 0, scr, r, lane);
    }
    for (int i = cx.bid * NTHR + tid; i < 16 * 1024; i += G * NTHR) { const int n = i >> 10, k = i & 1023; ((bf16*)(ws + WS_WIN_O))[(size_t)(4096 + n) * 1024 + k] = f2bf(INP(26)[(size_t)k * 4112 + 4096 + n]); }
    __syncthreads();
    LAS float* sc = (LAS float*)(lds + 73728);
    LAS float* part = (LAS float*)(lds + 90112);
    for (int bi = cx.bid; bi < 144; bi += G) {
        const int l = bi / 72, n0 = (bi - l * 72) * 128;
        for (int i = tid; i < 4096; i += NTHR) { const float v = INP(1)[i]; sc[i] = v * sigmoidf_(v); }
        __syncthreads();
        float acc[4][2];
#pragma unroll
        for (int b = 0; b < 4; ++b) { acc[b][0] = 0.f; acc[b][1] = 0.f; }
        const float* wp = INP(3) + ((size_t)l * 1024 + wave * 128) * NMOD + n0 + 2 * lane;
#pragma unroll 8
        for (int k = 0; k < 128; ++k) {
            const f32x2 wv = *(const f32x2*)(wp + (size_t)k * NMOD);
#pragma unroll
            for (int b = 0; b < 4; ++b) { const float s = sc[b * 1024 + wave * 128 + k]; acc[b][0] += s * wv.x; acc[b][1] += s * wv.y; }
        }
#pragma unroll
        for (int b = 0; b < 4; ++b) { part[(wave * 4 + b) * 128 + 2 * lane] = acc[b][0]; part[(wave * 4 + b) * 128 + 2 * lane + 1] = acc[b][1]; }
        __syncthreads();
        { const int b = tid >> 7, col = tid & 127; float s = INP(4)[(size_t)l * NMOD + n0 + col];
#pragma unroll
          for (int w = 0; w < 8; ++w) s += part[(w * 4 + b) * 128 + col];
          ((float*)(ws + WS_MOD))[(size_t)(l * 4 + b) * NMOD + n0 + col] = s; }
        __syncthreads();
    }
}

__device__ __forceinline__ void mod0_phase(const Args& a, const Ctx& cx) {
    unsigned char* ws = cx.ws;
    const int tid = cx.tid, lane = tid & 63, wave = tid >> 6;
    const int gw = cx.bid * NWAVES + wave, NGW = cx.G * NWAVES;
    const float* x = INP(0); const float* mod = (const float*)(ws + WS_MOD);
    bf16* XT = (bf16*)(ws + WS_A); float* ssq = (float*)(ws + WS_SSQ);
    for (int row = gw; row < T; row += NGW) {
        const int b = row >> 12;
        const float* scp = mod + (size_t)b * NMOD + DM;
        const f32x4* xr = (const f32x4*)(x + (size_t)row * DM) + lane;
        f32x4 v[4]; float ss = 0.f;
#pragma unroll
        for (int j = 0; j < 4; ++j) { v[j] = xr[64 * j]; ss += (v[j].x * v[j].x + v[j].y * v[j].y) + (v[j].z * v[j].z + v[j].w * v[j].w); }
        ss = wave_sum(ss);
        if (lane == 0) *(f32x4*)(ssq + (size_t)row * 4) = (f32x4){ss, 0.f, 0.f, 0.f};
        u32x2* o8 = (u32x2*)(XT + (size_t)row * DM) + lane;
#pragma unroll
        for (int j = 0; j < 4; ++j) {
            const f32x4 s4 = *((const f32x4*)scp + lane + 64 * j);
            const f32x4 y = v[j] * (s4 + 1.0f);
            u32x2 w; w.x = pk2(y.x, y.y); w.y = pk2(y.z, y.w); o8[64 * j] = w;
        }
    }
    for (int mi = 0; mi < 6; ++mi) {
        const int l = mi / 3, w3 = mi - l * 3;
        const bf16* Wt; int N; float* out;
        if (w3 == 1) { Wt = (const bf16*)(ws + (l == 0 ? WS_WIN_E : WS_WIN_O)); N = l == 0 ? 3840 : 4352; out = (float*)(ws + WS_BIASV) + (l == 0 ? BV_IN_E : BV_IN_O); }
        else { const int lf = l * 2 + (w3 >> 1); Wt = (const bf16*)(ws + WS_WGU) + (size_t)lf * 5632 * 1024; N = 5632; out = (float*)(ws + WS_BIASV) + (size_t)lf * 4 * 5632; }
        f32x4 sh[4][4];
#pragma unroll
        for (int b = 0; b < 4; ++b)
#pragma unroll
            for (int j = 0; j < 4; ++j) sh[b][j] = *(const f32x4*)(mod + (size_t)(l * 4 + b) * NMOD + (3 * w3) * DM + 16 * lane + 4 * j);
        u32x4 w0 = {0u, 0u, 0u, 0u}, w1 = {0u, 0u, 0u, 0u};
        if (gw < N) { w0 = *(const u32x4*)(Wt + (size_t)gw * 1024 + 16 * lane); w1 = *(const u32x4*)(Wt + (size_t)gw * 1024 + 16 * lane + 8); }
        for (int n = gw; n < N; n += NGW) {
            const int nn = n + NGW < N ? n + NGW : n;
            const u32x4 nw0 = *(const u32x4*)(Wt + (size_t)nn * 1024 + 16 * lane), nw1 = *(const u32x4*)(Wt + (size_t)nn * 1024 + 16 * lane + 8);
            float wf[16];
#pragma unroll
            for (int e = 0; e < 4; ++e) { wf[2 * e] = __uint_as_float(w0[e] << 16); wf[2 * e + 1] = __uint_as_float(w0[e] & 0xffff0000u); wf[8 + 2 * e] = __uint_as_float(w1[e] << 16); wf[8 + 2 * e + 1] = __uint_as_float(w1[e] & 0xffff0000u); }
            float sb[4];
#pragma unroll
            for (int b = 0; b < 4; ++b) { float s_ = 0.f;
#pragma unroll
                for (int j = 0; j < 4; ++j) s_ += (sh[b][j].x * wf[4 * j] + sh[b][j].y * wf[4 * j + 1]) + (sh[b][j].z * wf[4 * j + 2] + sh[b][j].w * wf[4 * j + 3]);
                sb[b] = s_; }
            const bool h5 = lane & 32, h4 = lane & 16;
            const float t0 = (h5 ? sb[2] : sb[0]) + __shfl_xor(h5 ? sb[0] : sb[2], 32);
            const float t1 = (h5 ? sb[3] : sb[1]) + __shfl_xor(h5 ? sb[1] : sb[3], 32);
            float u_ = (h4 ? t1 : t0) + __shfl_xor(h4 ? t0 : t1, 16);
            u_ += __shfl_xor(u_, 8); u_ += __shfl_xor(u_, 4); u_ += __shfl_xor(u_, 2); u_ += __shfl_xor(u_, 1);
            if ((lane & 15) == 0) out[(size_t)(((lane >> 5) & 1) * 2 + ((lane >> 4) & 1)) * N + n] = u_;
            w0 = nw0; w1 = nw1;
        }
    }
}

__constant__ const double ROPE_REV64[32] = {0.15915494309189535, 0.11934937021124886, 0.08949940160889101, 0.06711508300522726, 0.050329212104487035, 0.03774158471741977, 0.0283021958306234, 0.02122365276477766, 0.015915494309189534, 0.011934937021124886, 0.008949940160889102, 0.006711508300522725, 0.005032921210448704, 0.003774158471741977, 0.00283021958306234, 0.0021223652764777662, 0.0015915494309189536, 0.0011934937021124885, 0.0008949940160889102, 0.0006711508300522726, 0.0005032921210448703, 0.00037741584717419774, 0.00028302195830623395, 0.0002122365276477766, 0.00015915494309189535, 0.00011934937021124886, 8.949940160889102e-05, 6.711508300522725e-05, 5.0329212104487035e-05, 3.774158471741978e-05, 2.8302195830623396e-05, 2.122365276477766e-05};
__constant__ const double ROPE_REV32[16] = {0.15915494309189535, 0.08949940160889101, 0.050329212104487035, 0.0283021958306234, 0.015915494309189534, 0.008949940160889102, 0.005032921210448704, 0.00283021958306234, 0.0015915494309189536, 0.0008949940160889102, 0.0005032921210448703, 0.00028302195830623395, 0.00015915494309189535, 8.949940160889102e-05, 5.0329212104487035e-05, 2.8302195830623396e-05};
__device__ __forceinline__ void rope_cs(int pos, int i, int dim, float& c, float& s) {
    const double rev = (double)pos * (dim == 64 ? ROPE_REV64[i] : ROPE_REV32[i]);
    const float fr = (float)__builtin_amdgcn_fract(rev);
    s = __builtin_amdgcn_sinf(fr); c = __builtin_amdgcn_cosf(fr);
}

__device__ __forceinline__ void unpack8(const u32x4 w, float (&x)[8]) {
#pragma unroll
    for (int e = 0; e < 4; ++e) { x[2 * e] = __uint_as_float(w[e] << 16); x[2 * e + 1] = __uint_as_float(w[e] & 0xffff0000u); }
}
__device__ __forceinline__ u32x4 pack8(const float (&x)[8]) { u32x4 w; w.x = pk2(x[0], x[1]); w.y = pk2(x[2], x[3]); w.z = pk2(x[4], x[5]); w.w = pk2(x[6], x[7]); return w; }
template <bool ROPE>
__device__ __forceinline__ void prep_qk_token(bf16* __restrict__ qk, const float* __restrict__ gq, const float* __restrict__ gk, float qscale, int pos, int lane) {
    const int cc = lane & 7;
    float cs[8], sn[8], gqv[8], gkv[8];
#pragma unroll
    for (int e = 0; e < 8; ++e) { gqv[e] = gq[8 * cc + e]; gkv[e] = gk[8 * cc + e]; cs[e] = 1.f; sn[e] = 0.f; if (ROPE) rope_cs(pos, (8 * cc + e) & 31, 64, cs[e], sn[e]); }
    u32x4 raw[4];
#pragma unroll
    for (int j = 0; j < 4; ++j) raw[j] = *((const u32x4*)qk + lane + 64 * j);
#pragma unroll
    for (int j = 0; j < 4; ++j) {
        u32x4* p = (u32x4*)qk + lane + 64 * j;
        float x[8]; unpack8(raw[j], x);
        float ss = 0.f;
#pragma unroll
        for (int e = 0; e < 8; ++e) ss += x[e] * x[e];
        ss += __shfl_xor(ss, 1); ss += __shfl_xor(ss, 2); ss += __shfl_xor(ss, 4);
        const float rinv = __builtin_amdgcn_rsqf(ss * (1.0f / 64.0f) + EPS);
        const bool isq = j < 2;
        float o[8];
#pragma unroll
        for (int e = 0; e < 8; ++e) {
            const float y = x[e] * rinv * (isq ? gqv[e] : gkv[e]);
            float r = y;
            if (ROPE) { const float pr = __shfl_xor(y, 4); r = (cc < 4) ? (y * cs[e] - pr * sn[e]) : (y * cs[e] + pr * sn[e]); }
            o[e] = isq ? r * qscale : r;
        }
        *p = pack8(o);
    }
}

__device__ __forceinline__ void prep1e_phase(const Args& a, const Ctx& cx) {
    unsigned char* ws = cx.ws;
    const int tid = cx.tid, lane = tid & 63, wave = tid >> 6;
    const int gw = cx.bid * NWAVES + wave, NGW = cx.G * NWAVES;
    const int* positions = (const int*)INP(2);
    const float qscale = 0.125f * LOG2E;
    for (int t = gw; t < T; t += NGW) {
        const u32x4* lat = (const u32x4*)((const bf16*)(ws + WS_LAT) + (size_t)t * 768);
        const u32x4 lq = lat[lane < 48 ? lane : 0], lkv = lat[48 + (lane & 31)];
        prep_qk_token<true>((bf16*)(ws + WS_QK) + (size_t)t * 2048, INP(16), INP(17), qscale, positions[t], lane);
        {
            float x[8]; float ss = 0.f;
            if (lane < 48) { unpack8(lq, x);
#pragma unroll
                for (int e = 0; e < 8; ++e) ss += x[e] * x[e]; }
            const float rinv = __builtin_amdgcn_rsqf(wave_sum(ss) * (1.0f / 384.0f) + EPS);
            if (lane < 48) { float o[8];
#pragma unroll
                for (int e = 0; e < 8; ++e) o[e] = x[e] * rinv * INP(14)[8 * lane + e];
                ((u32x4*)((bf16*)(ws + WS_CQN) + (size_t)t * 384))[lane] = pack8(o); }
        }
        {
            float x[8]; float ss = 0.f;
            if (lane < 32) { unpack8(lkv, x);
#pragma unroll
                for (int e = 0; e < 8; ++e) ss += x[e] * x[e]; }
            const float rinv = __builtin_amdgcn_rsqf(wave_sum(ss) * (1.0f / 256.0f) + EPS);
            if (lane < 32) { float o[8];
#pragma unroll
                for (int e = 0; e < 8; ++e) o[e] = x[e] * rinv * INP(15)[8 * lane + e];
                ((u32x4*)((bf16*)(ws + WS_CKVN) + (size_t)t * 256))[lane] = pack8(o); }
        }
    }
}

__device__ __forceinline__ void prep2e_phase(const Args& a, const Ctx& cx) {
    unsigned char* ws = cx.ws;
    const int tid = cx.tid, lane = tid & 63, wave = tid >> 6;
    const int gw = cx.bid * NWAVES + wave, NGW = cx.G * NWAVES;
    const int* positions = (const int*)INP(2);
    const int cl = lane & 15, grp = lane >> 4;
    const bool act = cl < 12, isr = cl >= 8;
    const float qscale = 0.10206207261596575f * LOG2E;
    float gqv[8], gkv[8];
#pragma unroll
    for (int e = 0; e < 8; ++e) { gqv[e] = act ? INP(18)[8 * cl + e] : 0.f; gkv[e] = act ? INP(19)[8 * cl + e] : 0.f; }
    for (int t = gw; t < T; t += NGW) {
        const int pos = positions[t];
        float cs[8], sn[8];
#pragma unroll
        for (int e = 0; e < 8; ++e) rope_cs(pos, 8 * (cl & 1) + e, 32, cs[e], sn[e]);
        bf16* qb = (bf16*)(ws + WS_QB) + (size_t)t * 768;
        const bf16* kvb = (const bf16*)(ws + WS_KVB) + (size_t)t * 1536;
        const bf16* lat = (const bf16*)(ws + WS_LAT) + (size_t)t * 768;
        bf16* kbo = (bf16*)(ws + WS_KB) + (size_t)t * 768;
        u32x4 raw[2][2];
#pragma unroll
        for (int j = 0; j < 2; ++j)
#pragma unroll
            for (int qk = 0; qk < 2; ++qk) {
                const int head = 4 * j + grp;
                raw[j][qk] = (u32x4){0u, 0u, 0u, 0u};
                if (act) {
                    if (qk == 0) raw[j][qk] = *(const u32x4*)(qb + head * 96 + 8 * cl);
                    else if (!isr) raw[j][qk] = *(const u32x4*)(kvb + head * 192 + 8 * cl);
                    else raw[j][qk] = *(const u32x4*)(lat + 640 + 8 * (cl - 8));
                }
            }
#pragma unroll
        for (int j = 0; j < 2; ++j) {
            const int head = 4 * j + grp;
#pragma unroll
            for (int qk = 0; qk < 2; ++qk) {
                float x[8]; unpack8(raw[j][qk], x);
                float ss = 0.f;
#pragma unroll
                for (int e = 0; e < 8; ++e) ss += x[e] * x[e];
                ss += __shfl_xor(ss, 1); ss += __shfl_xor(ss, 2); ss += __shfl_xor(ss, 4); ss += __shfl_xor(ss, 8);
                const float rinv = __builtin_amdgcn_rsqf(ss * (1.0f / 96.0f) + EPS);
                float o[8];
#pragma unroll
                for (int e = 0; e < 8; ++e) {
                    const float y = x[e] * rinv * (qk == 0 ? gqv[e] : gkv[e]);
                    const float pr = __shfl_xor(y, 2);
                    float r = y;
                    if (isr) r = (cl < 10) ? (y * cs[e] - pr * sn[e]) : (y * cs[e] + pr * sn[e]);
                    o[e] = qk == 0 ? r * qscale : r;
                }
                if (act) { if (qk == 0) *(u32x4*)(qb + head * 96 + 8 * cl) = pack8(o); else *(u32x4*)(kbo + head * 96 + 8 * cl) = pack8(o); }
            }
        }
    }
}

__device__ __forceinline__ void prepo_phase(const Args& a, const Ctx& cx, LAS unsigned char* lds) {
    unsigned char* ws = cx.ws;
    const int tid = cx.tid, lane = tid & 63, wave = tid >> 6;
    const int gw = cx.bid * NWAVES + wave, NGW = cx.G * NWAVES;
    const float qscale = 0.125f * LOG2E;
    {
        const int cc = lane & 7;
        float gqv[8], gkv[8];
#pragma unroll
        for (int e = 0; e < 8; ++e) { gqv[e] = INP(28)[8 * cc + e] * qscale; gkv[e] = INP(29)[8 * cc + e]; }
        for (int t = gw; t < T; t += NGW) {
            const int b = t >> 12, sq_ = t & (SEQ - 1);
            u32x4* pp[4]; u32x4 raw[4];
#pragma unroll
            for (int j = 0; j < 4; ++j) {
                const int v = (lane >> 3) + 8 * j;
                pp[j] = (j < 2) ? (u32x4*)((bf16*)(ws + WS_QK) + (size_t)t * 1024 + v * 64 + 8 * cc)
                                : (u32x4*)((bf16*)(ws + WS_KH) + ((size_t)(b * 16 + v - 16) * SEQ + sq_) * 64 + 8 * cc);
                raw[j] = *pp[j];
            }
#pragma unroll
            for (int j = 0; j < 4; ++j) {
                u32x4* p = pp[j];
                float x[8]; unpack8(raw[j], x);
                float ss = 0.f;
#pragma unroll
                for (int e = 0; e < 8; ++e) ss += x[e] * x[e];
                ss += __shfl_xor(ss, 1); ss += __shfl_xor(ss, 2); ss += __shfl_xor(ss, 4);
                const float rinv = __builtin_amdgcn_rsqf(ss * (1.0f / 64.0f) + EPS);
                float o[8];
#pragma unroll
                for (int e = 0; e < 8; ++e) o[e] = x[e] * rinv * (j < 2 ? gqv[e] : gkv[e]);
                *p = pack8(o);
            }
        }
    }
    LAS double* sd = (LAS double*)lds;
    for (int sq = cx.bid; sq < 64; sq += cx.G) {
        const int b = sq >> 4, hd = sq & 15; const float bfv = INP(27)[hd];
        const float* F = (const float*)(ws + WS_FLOG) + ((size_t)b * SEQ + 8 * tid) * 16 + hd;
        double pre[8]; double run = 0.0;
#pragma unroll
        for (int e = 0; e < 8; ++e) { const float z = F[e * 16] + bfv; const float lf = fminf(z, 0.f) - __logf(1.0f + __expf(-fabsf(z))); run += (double)lf; pre[e] = run; }
        __syncthreads();
        sd[tid] = run; __syncthreads();
        int cur = 0;
        for (int off = 1; off < 512; off <<= 1) { double v = sd[cur * 512 + tid]; if (tid >= off) v += sd[cur * 512 + tid - off]; sd[(cur ^ 1) * 512 + tid] = v; __syncthreads(); cur ^= 1; }
        const double excl = sd[cur * 512 + tid] - run;
        u32x4* QA = (u32x4*)((bf16*)(ws + WS_QAUG) + ((size_t)sq * SEQ + 8 * tid) * 8);
        u32x4* KA = (u32x4*)((bf16*)(ws + WS_KAUG) + ((size_t)sq * SEQ + 8 * tid) * 16);
#pragma unroll
        for (int e = 0; e < 8; ++e) {
            const float c = (float)((excl + pre[e]) * (double)LOG2E);
            float c0, c1, c2; split3(c, c0, c1, c2);
            u32x4 qa; qa.x = pk2(c0, c1); qa.y = pk2(c2, 1.f); qa.z = pk2(1.f, 1.f); qa.w = 0u;
            u32x4 k0; k0.x = pk2(1.f, 1.f); k0.y = pk2(1.f, -c0); k0.z = pk2(-c1, -c2); k0.w = 0u;
            u32x4 k1; k1.x = pk2(1.f, 1.f); k1.y = pk2(1.f, 0.f); k1.z = 0u; k1.w = 0u;
            QA[e] = qa; KA[2 * e] = k0; KA[2 * e + 1] = k1;
        }
        __syncthreads();
    }
}

#define MFMA32(a, b, c) __builtin_amdgcn_mfma_f32_32x32x16_bf16((a), (b), (c), 0, 0, 0)
typedef short v4i16_t __attribute__((ext_vector_type(4)));
__device__ __forceinline__ s16x4 vtr(LAS const unsigned char* p) { return __builtin_bit_cast(s16x4, __builtin_amdgcn_ds_read_tr16_b64_v4i16((LAS v4i16_t*)p)); }

template <int DKT>
__device__ __forceinline__ void qk_tile_plain(f32x16 (&sa)[2], LAS const unsigned char* kbase, const bf16x8 (&q)[DKT / 16], int r, int h) {
    constexpr int KSTR = DKT + 8;
#pragma unroll
    for (int kb = 0; kb < 2; ++kb) {
#pragma unroll
        for (int i = 0; i < 16; ++i) sa[kb][i] = 0.f;
#pragma unroll
        for (int s = 0; s < DKT / 16; ++s) { const bf16x8 kf = *(LAS const bf16x8*)(kbase + ((32 * kb + r) * KSTR + 16 * s + 8 * h) * 2); sa[kb] = MFMA32(kf, q[s], sa[kb]); }
    }
}
__device__ __forceinline__ float max3f(float a, float b, float c) { return fmaxf(fmaxf(a, b), c); }

constexpr float ATT_THR = 8.0f;
#ifndef ATT_DEEP
#define ATT_DEEP(DK, DV) ((DK) == 64)
#endif
template <int DK, int DV, bool AUG>
__device__ __forceinline__ void attn_pass(const Ctx& cx, LAS unsigned char* lds, const bf16* __restrict__ Qg, int qp, const bf16* __restrict__ Kg, int kp, const bf16* __restrict__ Vg, int vp,
                                          const bf16* __restrict__ qaug, const bf16* __restrict__ kaug, int qb, f32x16 (&o)[DV / 32]) {
    constexpr int DKT = DK + (AUG ? 16 : 0), KSTR = DKT + 8, VSTR = DV + 32, KBY = 64 * KSTR * 2, VBY = 64 * VSTR * 2;
    constexpr int OFF_K = 0, OFF_V = 2 * KBY, ATT_BYTES = 2 * KBY + 2 * VBY;
    constexpr int KCPR = DK / 8, VCPR = DV / 8, NKC = 64 * KCPR, NVC = 64 * VCPR, NS = DKT / 16, NQK = 2 * NS;
    static_assert(ATT_BYTES <= LDS_MAIN && (DK != 64 || DV != 128 || ATT_BYTES <= 65536), "attention LDS (the differential pass parks its first map at 64 KiB)");
    const int tid = cx.tid, lane = tid & 63, r = lane & 31, h = lane >> 5, wid = __builtin_amdgcn_readfirstlane(tid >> 6);
    const int R0 = qb * 256 + wid * 32;
    const GAS bf16* Qg1 = (const GAS bf16*)Qg; const GAS bf16* Kg1 = (const GAS bf16*)Kg; const GAS bf16* Vg1 = (const GAS bf16*)Vg; const GAS bf16* qaug1 = (const GAS bf16*)qaug; const GAS bf16* kaug1 = (const GAS bf16*)kaug;
    bf16x8 q[NS];
#pragma unroll
    for (int s = 0; s < DK / 16; ++s) q[s] = *(const GAS bf16x8*)(Qg1 + (size_t)(R0 + r) * qp + 16 * s + 8 * h);
    if (AUG) { q[NS - 1] = (bf16x8){0, 0, 0, 0, 0, 0, 0, 0}; if (h == 0) q[NS - 1] = *(const GAS bf16x8*)(qaug1 + (size_t)(R0 + r) * 8); }
#pragma unroll
    for (int d = 0; d < DV / 32; ++d)
#pragma unroll
        for (int i = 0; i < 16; ++i) o[d][i] = 0.f;
    float m = AUG ? 0.f : -1e30f, lsum = 0.f;
    const int nt = 4 * (qb + 1), jmax = 4 * qb + (wid >> 1);
    const int krow0 = tid / KCPR, kcol0 = (tid - krow0 * KCPR) * 8, krow1 = (tid + 512) / KCPR, kcol1 = ((tid + 512) - krow1 * KCPR) * 8;
    const int vrow0 = tid / VCPR, vcol0 = (tid - vrow0 * VCPR) * 8, vrow1 = (tid + 512) / VCPR, vcol1 = ((tid + 512) - vrow1 * VCPR) * 8;
    const bool k1 = (NKC > 512) && (tid + 512 < NKC);
    u32x4 kr0_0, kr1_0 = {0u, 0u, 0u, 0u}, vr0_0, vr1_0 = {0u, 0u, 0u, 0u}, ka_0 = {0u, 0u, 0u, 0u};
    u32x4 kr0_1, kr1_1 = {0u, 0u, 0u, 0u}, vr0_1, vr1_1 = {0u, 0u, 0u, 0u}, ka_1 = {0u, 0u, 0u, 0u};
    const int krow1c = krow1 < 64 ? krow1 : 63, karow = (tid >> 1) & 63;
#define ATT_LOADK(j, S) do { const size_t kb_ = (size_t)(j) * 64; \
        kr0_##S = *(const GAS u32x4*)(Kg1 + (kb_ + krow0) * kp + kcol0); if (NKC > 512) kr1_##S = *(const GAS u32x4*)(Kg1 + (kb_ + krow1c) * kp + kcol1); \
        if (AUG) ka_##S = *(const GAS u32x4*)(kaug1 + (kb_ + karow) * 16 + (tid & 1) * 8); } while (0)
#define ATT_LOADV(j, S) do { const size_t kb_ = (size_t)(j) * 64; \
        vr0_##S = *(const GAS u32x4*)(Vg1 + (kb_ + vrow0) * vp + vcol0); if (NVC > 512) vr1_##S = *(const GAS u32x4*)(Vg1 + (kb_ + vrow1) * vp + vcol1); } while (0)
#define ATT_STOREK(buf, S) do { LAS unsigned char* b_ = lds + OFF_K + (buf) * KBY; \
        *(LAS u32x4*)(b_ + (krow0 * KSTR + kcol0) * 2) = kr0_##S; if (k1) *(LAS u32x4*)(b_ + (krow1 * KSTR + kcol1) * 2) = kr1_##S; \
        if (AUG && tid < 128) *(LAS u32x4*)(b_ + ((tid >> 1) * KSTR + DK + (tid & 1) * 8) * 2) = ka_##S; } while (0)
#define ATT_STOREV(buf, S) do { LAS unsigned char* b_ = lds + OFF_V + (buf) * VBY; \
        *(LAS u32x4*)(b_ + (vrow0 * VSTR + vcol0) * 2) = vr0_##S; if (NVC > 512) *(LAS u32x4*)(b_ + (vrow1 * VSTR + vcol1) * 2) = vr1_##S; } while (0)
    constexpr bool DEEP = ATT_DEEP(DK, DV);
    ATT_LOADK(0, 0); ATT_LOADV(0, 0); ATT_LOADK(1, 1);
    ATT_STOREK(0, 0); ATT_STOREV(0, 0); ATT_STOREK(1, 1);
    if (DEEP) { ATT_LOADK(2, 1); ATT_LOADV(1, 1); }
    __syncthreads();
    f32x16 sc[2], sn[2];
    qk_tile_plain<DKT>(sc, lds + OFF_K, q, r, h);
    __syncthreads();
    const int voff = (((lane & 15) >> 2) + 4 * h) * VSTR * 2 + ((lane >> 4) & 1) * 32 + (lane & 3) * 8;
    const int koff = (r * KSTR + 8 * h) * 2;
    for (int j2 = 0; j2 < nt; j2 += 2) {
#pragma unroll
      for (int half = 0; half < 2; ++half) {
        const int j = j2 + half;
        constexpr int LA = DEEP ? 1 : 0;
        if (DEEP) {
            if (half == 0) { ATT_STOREK(0, 1); ATT_STOREV(1, 1); } else { ATT_STOREK(1, 0); ATT_STOREV(0, 0); }
        }
        { const int jk = (j + 2 + LA < nt) ? j + 2 + LA : nt - 1, jv = (j + 1 + LA < nt) ? j + 1 + LA : nt - 1;
          if (half == 0) { ATT_LOADK(jk, 0); ATT_LOADV(jv, 0); } else { ATT_LOADK(jk, 1); ATT_LOADV(jv, 1); } }
        if (j <= jmax) {
            LAS const unsigned char* kn = lds + OFF_K + ((j + 1) & 1) * KBY + koff;
            LAS const unsigned char* vbase = lds + OFF_V + (j & 1) * VBY + voff;
            if (j == jmax) {
                const int qrow = R0 + r;
#pragma unroll
                for (int kb = 0; kb < 2; ++kb)
#pragma unroll
                    for (int i = 0; i < 16; ++i) { const int key = 64 * j + 32 * kb + crow(i, h); if (key > qrow) sc[kb][i] = -1e30f; }
            }
            float mx = max3f(sc[0][0], sc[0][1], sc[1][0]);
#pragma unroll
            for (int i = 2; i < 16; i += 2) mx = max3f(mx, sc[0][i], sc[0][i + 1]);
#pragma unroll
            for (int i = 1; i < 15; i += 2) mx = max3f(mx, sc[1][i], sc[1][i + 1]);
            mx = fmaxf(mx, sc[1][15]);
            mx = fmaxf(mx, __shfl_xor(mx, 32));
            if (AUG) {
                if (__builtin_amdgcn_ballot_w64(mx > ATT_THR) != 0ull) {
                    const float dlt = fmaxf(mx, 0.f), alpha = fexp2(-dlt); m += dlt; lsum *= alpha;
#pragma unroll
                    for (int d = 0; d < DV / 32; ++d)
#pragma unroll
                        for (int i = 0; i < 16; ++i) o[d][i] *= alpha;
#pragma unroll
                    for (int kb = 0; kb < 2; ++kb)
#pragma unroll
                        for (int i = 0; i < 16; ++i) sc[kb][i] -= dlt;
                    const bf16x8 mf = split3frag(-m);
                    if (h == 1) q[NS - 1] = mf;
                }
            } else if (__builtin_amdgcn_ballot_w64(mx > m + ATT_THR) != 0ull) {
                const float mn = fmaxf(m, mx), alpha = fexp2(m - mn); m = mn; lsum *= alpha;
#pragma unroll
                for (int d = 0; d < DV / 32; ++d)
#pragma unroll
                    for (int i = 0; i < 16; ++i) o[d][i] *= alpha;
            }
#pragma unroll
            for (int kb = 0; kb < 2; ++kb)
#pragma unroll
                for (int i = 0; i < 16; ++i) sn[kb][i] = 0.f;
            bf16x8 pf[2][2];
            bf16x8 kfr[10][2];
            float ps = 0.f;
#define KFRAG(t) (*(LAS const bf16x8*)(kn + ((32 * ((t) & 1)) * KSTR + 16 * ((t) >> 1)) * 2))
#define VREAD(g, d, LO, HI) do { LAS const unsigned char* vp_ = vbase + (16 * (g)) * VSTR * 2 + 64 * (d); LO = vtr(vp_); HI = vtr(vp_ + 8 * VSTR * 2); } while (0)
            s16x4 vlo[5][DV / 32], vhi[5][DV / 32];
#pragma unroll
            for (int c0 = 0; c0 < 2; ++c0)
#pragma unroll
                for (int t = c0 * NQK / 8; t < (c0 + 1) * NQK / 8; ++t) kfr[c0][t - c0 * NQK / 8] = KFRAG(t);
            __builtin_amdgcn_sched_barrier(0);
#pragma unroll
            for (int c = 0; c < 8; ++c) {
                if (c + 2 < 8) {
#pragma unroll
                    for (int t = (c + 2) * NQK / 8; t < (c + 3) * NQK / 8; ++t) kfr[c + 2][t - (c + 2) * NQK / 8] = KFRAG(t);
                } else if (c == 6) {
#pragma unroll
                    for (int d = 0; d < DV / 32; ++d) VREAD(0, d, vlo[0][d], vhi[0][d]);
                }
#pragma unroll
                for (int t = c * NQK / 8; t < (c + 1) * NQK / 8; ++t) sn[t & 1] = MFMA32(kfr[c][t - c * NQK / 8], q[t >> 1], sn[t & 1]);
                const int kbc = c >> 2, i0 = 4 * (c & 3);
#pragma unroll
                for (int e = 0; e < 4; ++e) { const float p = AUG ? fexp2(sc[kbc][i0 + e]) : fexp2(sc[kbc][i0 + e] - m); sc[kbc][i0 + e] = p; ps += p; }
                if (c & 1) {
                    const int s8 = 8 * ((c & 3) >> 1);
                    u32x4 w; w.x = pk2(sc[kbc][s8], sc[kbc][s8 + 1]); w.y = pk2(sc[kbc][s8 + 2], sc[kbc][s8 + 3]); w.z = pk2(sc[kbc][s8 + 4], sc[kbc][s8 + 5]); w.w = pk2(sc[kbc][s8 + 6], sc[kbc][s8 + 7]);
                    pf[kbc][(c & 3) >> 1] = __builtin_bit_cast(bf16x8, w);
                }
                __builtin_amdgcn_sched_barrier(0);
            }
            lsum += ps;
#pragma unroll
            for (int g = 0; g < 4; ++g) {
                if (g + 1 < 4) {
#pragma unroll
                    for (int d = 0; d < DV / 32; ++d) VREAD(g + 1, d, vlo[g + 1][d], vhi[g + 1][d]);
                }
#pragma unroll
                for (int d = 0; d < DV / 32; ++d) {
                    const bf16x8 vf = __builtin_shufflevector(vlo[g][d], vhi[g][d], 0, 1, 2, 3, 4, 5, 6, 7);
                    o[d] = MFMA32(vf, pf[g >> 1][g & 1], o[d]);
                }
                __builtin_amdgcn_sched_barrier(0);
            }
#undef KFRAG
#undef VREAD
            sc[0] = sn[0]; sc[1] = sn[1];
        }
        if (!DEEP) { if (half == 0) { ATT_STOREK(0, 0); ATT_STOREV(1, 0); } else { ATT_STOREK(1, 1); ATT_STOREV(0, 1); } }
        __syncthreads();
      }
    }
#undef ATT_LOADK
#undef ATT_LOADV
#undef ATT_STOREK
#undef ATT_STOREV
    const float l = lsum + __shfl_xor(lsum, 32), inv = __builtin_amdgcn_rcpf(l);
#pragma unroll
    for (int d = 0; d < DV / 32; ++d)
#pragma unroll
        for (int i = 0; i < 16; ++i) o[d][i] *= inv;
}

__device__ __forceinline__ bool attn_next(const Ctx& cx, int i, int NU, int NBH, int& bh, int& qb) {
    const int G = cx.G, c = cx.bid;
    if (G == 256) {
        if (i >= NBH / 16) return false;
        const int x = c & 7, ci = c >> 3, g = ci >> 4, k = ci & 15;
        bh = x + 8 * (2 * i + g); qb = (i & 1) ? k : 15 - k; return true;
    }
    const int u = i * G + ((i & 1) ? (G - 1 - c) : c);
    if (u >= NU) return false;
    qb = 15 - u / NBH; bh = u % NBH; return true;
}

__device__ __forceinline__ void attn_diff_phase(const Args& a, const Ctx& cx, LAS unsigned char* lds) {
    unsigned char* ws = cx.ws;
    const int tid = cx.tid, lane = tid & 63, r = lane & 31, h = lane >> 5, wid = tid >> 6;
    const float lambda_init = 0.2f;
    const float lam = __expf(wave_sum(INP(20)[lane] * INP(21)[lane])) - __expf(wave_sum(INP(22)[lane] * INP(23)[lane])) + lambda_init;
    const float* subg = INP(24);
    int bh, qb;
    for (int it = 0; attn_next(cx, it, 512, 32, bh, qb); ++it) {
        const int b = bh >> 3, hd = bh & 7;
        const bf16* Q = (const bf16*)(ws + WS_QK) + (size_t)b * SEQ * 2048 + hd * 128;
        const bf16* K = Q + 1024;
        const bf16* V = (const bf16*)(ws + WS_VA) + (size_t)b * SEQ * 1024 + hd * 128;
        f32x16 o1[4];
        attn_pass<64, 128, false>(cx, lds, Q, 2048, K, 2048, V, 1024, nullptr, nullptr, qb, o1);
        LAS unsigned* park = (LAS unsigned*)(lds + 65536 + wid * 8192) + lane;
#pragma unroll
        for (int d = 0; d < 4; ++d)
#pragma unroll
            for (int i = 0; i < 8; ++i) park[(d * 8 + i) * 64] = pk2(o1[d][2 * i], o1[d][2 * i + 1]);
        attn_pass<64, 128, false>(cx, lds, Q + 64, 2048, K + 64, 2048, V, 1024, nullptr, nullptr, qb, o1);
        float ss = 0.f;
#pragma unroll
        for (int d = 0; d < 4; ++d)
#pragma unroll
            for (int i = 0; i < 8; ++i) {
                const unsigned pw = park[(d * 8 + i) * 64];
                const float a0 = __uint_as_float(pw << 16), a1 = __uint_as_float(pw & 0xffff0000u);
                const float v0 = a0 - lam * o1[d][2 * i], v1 = a1 - lam * o1[d][2 * i + 1];
                o1[d][2 * i] = v0; o1[d][2 * i + 1] = v1; ss += v0 * v0 + v1 * v1;
            }
        ss += __shfl_xor(ss, 32);
        const float rinv = (1.0f - lambda_init) * __builtin_amdgcn_rsqf(ss * (1.0f / 128.0f) + EPS);
        bf16* O = (bf16*)(ws + WS_A) + ((size_t)b * SEQ + qb * 256 + wid * 32 + r) * 2048 + hd * 128;
#pragma unroll
        for (int d = 0; d < 4; ++d)
#pragma unroll
            for (int g = 0; g < 4; ++g) {
                const int dv = 32 * d + 8 * g + 4 * h; const f32x4 sg = *(const f32x4*)(subg + dv);
                u32x2 w; w.x = pk2(o1[d][4 * g] * rinv * sg.x, o1[d][4 * g + 1] * rinv * sg.y); w.y = pk2(o1[d][4 * g + 2] * rinv * sg.z, o1[d][4 * g + 3] * rinv * sg.w);
                *(u32x2*)(O + dv) = w;
            }
    }
}

__device__ __forceinline__ void attn_mla_phase(const Args& a, const Ctx& cx, LAS unsigned char* lds) {
    unsigned char* ws = cx.ws;
    const int tid = cx.tid, lane = tid & 63, r = lane & 31, h = lane >> 5, wid = tid >> 6;
    int bh, qb;
    for (int it = 0; attn_next(cx, it, 512, 32, bh, qb); ++it) {
        const int b = bh >> 3, hd = bh & 7;
        const bf16* Q = (const bf16*)(ws + WS_QB) + (size_t)b * SEQ * 768 + hd * 96;
        const bf16* K = (const bf16*)(ws + WS_KB) + (size_t)b * SEQ * 768 + hd * 96;
        const bf16* V = (const bf16*)(ws + WS_KVB) + (size_t)b * SEQ * 1536 + hd * 192 + 64;
        f32x16 o[4];
        attn_pass<96, 128, false>(cx, lds, Q, 768, K, 768, V, 1536, nullptr, nullptr, qb, o);
        bf16* O = (bf16*)(ws + WS_A) + ((size_t)b * SEQ + qb * 256 + wid * 32 + r) * 2048 + 1024 + hd * 128;
#pragma unroll
        for (int d = 0; d < 4; ++d)
#pragma unroll
            for (int g = 0; g < 4; ++g) { u32x2 w; w.x = pk2(o[d][4 * g], o[d][4 * g + 1]); w.y = pk2(o[d][4 * g + 2], o[d][4 * g + 3]); *(u32x2*)(O + 32 * d + 8 * g + 4 * h) = w; }
    }
}

__device__ __forceinline__ void attn_fox_phase(const Args& a, const Ctx& cx, LAS unsigned char* lds) {
    unsigned char* ws = cx.ws;
    const int tid = cx.tid, lane = tid & 63, r = lane & 31, h = lane >> 5, wid = tid >> 6;
    int bh, qb;
    for (int it = 0; attn_next(cx, it, 1024, 64, bh, qb); ++it) {
        const int b = bh >> 4, hd = bh & 15;
        const bf16* Q = (const bf16*)(ws + WS_QK) + (size_t)b * SEQ * 1024 + hd * 64;
        const bf16* K = (const bf16*)(ws + WS_KH) + (size_t)bh * SEQ * 64;
        const bf16* V = (const bf16*)(ws + WS_VA) + (size_t)bh * SEQ * 64;
        f32x16 o[2];
        attn_pass<64, 64, true>(cx, lds, Q, 1024, K, 64, V, 64, (const bf16*)(ws + WS_QAUG) + (size_t)bh * SEQ * 8, (const bf16*)(ws + WS_KAUG) + (size_t)bh * SEQ * 16, qb, o);
        const size_t ro = ((size_t)b * SEQ + qb * 256 + wid * 32 + r) * 1024 + hd * 64;
        bf16* O = (bf16*)(ws + WS_A) + ro; const bf16* OG = (const bf16*)(ws + WS_OG) + ro;
        u32x2 gvv[2][4];
#pragma unroll
        for (int d = 0; d < 2; ++d)
#pragma unroll
            for (int g = 0; g < 4; ++g) gvv[d][g] = *(const u32x2*)(OG + 32 * d + 8 * g + 4 * h);
#pragma unroll
        for (int d = 0; d < 2; ++d)
#pragma unroll
            for (int g = 0; g < 4; ++g) {
                const int dv = 32 * d + 8 * g + 4 * h; const u32x2 gv = gvv[d][g];
                const float g0 = __uint_as_float(gv.x << 16), g1 = __uint_as_float(gv.x & 0xffff0000u), g2 = __uint_as_float(gv.y << 16), g3 = __uint_as_float(gv.y & 0xffff0000u);
                u32x2 w; w.x = pk2(o[d][4 * g] * sigmoidf_(g0), o[d][4 * g + 1] * sigmoidf_(g1)); w.y = pk2(o[d][4 * g + 2] * sigmoidf_(g2), o[d][4 * g + 3] * sigmoidf_(g3));
                *(u32x2*)(O + dv) = w;
            }
    }
}

#define XB_TMO      128
#define XB_XCNT(j)  (256  + 64 * (j))
#define XB_XSUB(j)  (1280 + 64 * (j))
#define XB_XGEN(j)  (2304 + 64 * (j))
#define XB_TOP      3328
#define XB_TOPGEN   3392
#define XCD_BAR_WORDS 3456
#define XB_SPIN_CAP (1u << 18)

__device__ __forceinline__ unsigned xb_ld(unsigned* p)              { return __hip_atomic_load(p, __ATOMIC_RELAXED, __HIP_MEMORY_SCOPE_AGENT); }
__device__ __forceinline__ unsigned xb_add(unsigned* p, unsigned v) { return __hip_atomic_fetch_add(p, v, __ATOMIC_RELAXED, __HIP_MEMORY_SCOPE_AGENT); }
__device__ __forceinline__ unsigned xb_xcc_id() { return (unsigned)__builtin_amdgcn_s_getreg((3 << 11) | 20) & 0xFu; }
#define XB_SPIN(cond, bar) do { unsigned _sp = 0; while (cond) { __builtin_amdgcn_s_sleep(1); \
    if ((++_sp & 255u) == 0u) { if (xb_ld(&(bar)[XB_TMO])) break; if (_sp > XB_SPIN_CAP) { atomicAdd(&(bar)[XB_TMO], 1u); break; } } } } while (0)

struct XcdBarrier {
    unsigned* bar; unsigned x;
    volatile LAS unsigned* st;
};

__device__ __forceinline__ XcdBarrier xcd_barrier_post(unsigned* bar, volatile LAS unsigned* st) {
    XcdBarrier b; b.bar = bar; b.x = xb_xcc_id(); b.st = st;
    if (threadIdx.x == 0) (void)xb_add(&bar[XB_XCNT(b.x)], 1u);
    return b;
}
__device__ __forceinline__ void xcd_barrier_complete(unsigned* bar, unsigned x, unsigned& nloc, unsigned& nx) {
    const unsigned G = gridDim.x * gridDim.y * gridDim.z;
    unsigned sum, cnt, mine, sp = 0u;
    for (;;) {
        sum = 0u; cnt = 0u; mine = 0u;
#pragma unroll
        for (unsigned j = 0; j < 16; ++j) { const unsigned c = xb_ld(&bar[XB_XCNT(j)]); sum += c; cnt += (c > 0u) ? 1u : 0u; mine = (j == x) ? c : mine; }
        if (sum == G) break;
        __builtin_amdgcn_s_sleep(1);
        if ((++sp & 255u) == 0u) { if (xb_ld(&bar[XB_TMO])) break; if (sp > XB_SPIN_CAP) { atomicAdd(&bar[XB_TMO], 1u); break; } }
    }
    nloc = mine > 0u ? mine : 1u; nx = cnt > 0u ? cnt : 1u;
}

__device__ __forceinline__ void xcd_barrier(const XcdBarrier& b) {
    asm volatile("s_waitcnt vmcnt(0)" ::: "memory");
    __syncthreads();
    if (threadIdx.x == 0) {
        unsigned* bar = b.bar;
        __builtin_amdgcn_s_waitcnt(0);
        unsigned nloc = b.st[0], nx = b.st[1];
        if (nloc == 0u) { xcd_barrier_complete(bar, b.x, nloc, nx); b.st[0] = nloc; b.st[1] = nx; }
        const unsigned old = xb_add(&bar[XB_XSUB(b.x)], 1u);
        const unsigned gen = old / nloc;
        if (old + 1u == (gen + 1u) * nloc) {
            __builtin_amdgcn_fence(__ATOMIC_RELEASE, "agent");
            asm volatile("s_waitcnt vmcnt(0)" ::: "memory");
            const unsigned og = xb_add(&bar[XB_TOP], 1u);
            const unsigned tg = og / nx;
            if (og + 1u == (tg + 1u) * nx) xb_add(&bar[XB_TOPGEN], 1u);
            else XB_SPIN(xb_ld(&bar[XB_TOPGEN]) == tg, bar);
            __builtin_amdgcn_fence(__ATOMIC_ACQUIRE, "agent");
            xb_add(&bar[XB_XGEN(b.x)], 1u);
            asm volatile("s_waitcnt vmcnt(0)" ::: "memory");
        } else {
            XB_SPIN(xb_ld(&bar[XB_XGEN(b.x)]) == gen, bar);
            __builtin_amdgcn_fence(__ATOMIC_ACQUIRE, "agent");
            asm volatile("s_waitcnt vmcnt(0)" ::: "memory");
        }
    }
    __syncthreads();
}

enum { PH_PROLOGUE = 0, PH_MOD0, PH_GU, PH_DOWN, PH_IN, PH_PREP1E, PH_ATT_DIFF, PH_GEMM_MLA, PH_PREP2E, PH_ATT_MLA, PH_OUT, PH_PREPO, PH_ATT_FOX };
constexpr int NPHASES = 21;
__constant__ const unsigned char PH_TYPE[NPHASES] = {PH_PROLOGUE, PH_MOD0,
    PH_GU, PH_DOWN, PH_IN, PH_PREP1E, PH_ATT_DIFF, PH_GEMM_MLA, PH_PREP2E, PH_ATT_MLA, PH_OUT, PH_GU, PH_DOWN,
    PH_GU, PH_DOWN, PH_IN, PH_PREPO, PH_ATT_FOX, PH_OUT, PH_GU, PH_DOWN};
__constant__ const unsigned char PH_LAYER[NPHASES] = {0, 0, 0, 0, 0, 0, 0, 0, 0, 0, 0, 0, 0, 1, 1, 1, 1, 1, 1, 1, 1};
__constant__ const unsigned char PH_SUB[NPHASES] = {0, 0, 0, 0, 0, 0, 0, 0, 0, 0, 0, 1, 1, 0, 0, 0, 0, 0, 0, 1, 1};

__global__ void __launch_bounds__(NTHR, 2) mk_fwd(Args a) {
    extern __shared__ __attribute__((aligned(16))) unsigned char lds_raw[];
    LAS unsigned char* lds = (LAS unsigned char*)lds_raw;
    cg::grid_group grid = cg::this_grid();
    if (a.ph_lo < 0) grid.sync();
    volatile LAS unsigned* bst = (volatile LAS unsigned*)(lds + LDS_MAIN);
    if (threadIdx.x < 16) bst[threadIdx.x] = 0u;
    __syncthreads();
    const XcdBarrier bar = xcd_barrier_post((unsigned*)(a.ws + WS_CTL), bst);
    const int G = gridDim.x;
    for (int ph = a.ph_lo; ph < a.ph_hi; ++ph) {
        Ctx cx;
        { int zi; asm volatile("s_mov_b32 %0, 0" : "=s"(zi)); cx.zi = zi; }
        { int t_ = threadIdx.x; asm volatile("" : "+v"(t_)); cx.tid = t_; }
        { int b_ = blockIdx.x; asm volatile("" : "+s"(b_)); cx.bid = b_; }
        { int g_ = gridDim.x; asm volatile("" : "+s"(g_)); cx.G = g_; }
        unsigned char* ws = a.ws; asm volatile("" : "+s"(ws)); cx.ws = ws;
        const int G = cx.G;
        float* xbuf = a.out; asm volatile("" : "+s"(xbuf));
        const int type = PH_TYPE[ph], l = PH_LAYER[ph], sub = PH_SUB[ph];
        const float* modl = (const float*)(ws + WS_MOD) + (size_t)l * 4 * NMOD;
        if (type == PH_PROLOGUE) prologue_phase(a, cx, lds);
        else if (type == PH_MOD0) mod0_phase(a, cx);
        else if (type == PH_GU) {
            pg8::Gemm g{(const pg8::bf16_t*)(ws + (sub == 0 ? WS_A : WS_C)), (const pg8::bf16_t*)(ws + WS_WGU) + (size_t)(l * 2 + sub) * 5632 * 1024, T, 2 * FF, DM};
            pg8::StaticOrder S; S.init(T, 2 * FF, G, cx.bid);
            EpiSwiglu E{(bf16*)(ws + WS_ACT), FF, (const float*)(ws + WS_SSQ), (const float*)(ws + WS_BIASV) + (size_t)(l * 2 + sub) * 4 * 5632};
            pg8::gemm_phase<EpiSwiglu, pg8::StaticOrder, PG8_ALIGN, PG8_SP2>(lds, g, S, E, cx.tid);
        } else if (type == PH_DOWN || type == PH_OUT) {
            const bool isdown = type == PH_DOWN;
            const pg8::bf16_t* Ap = (const pg8::bf16_t*)(ws + (isdown ? WS_ACT : WS_A));
            const pg8::bf16_t* Bp = isdown ? (const pg8::bf16_t*)(ws + WS_WD) + (size_t)(l * 2 + sub) * 1024 * 2816 : (const pg8::bf16_t*)(ws + (l == 0 ? WS_WOUT_E : WS_WOUT_O));
            const int Kd = isdown ? FF : (l == 0 ? 2048 : 1024);
            const pg8::Gemm g{Ap, Bp, T, DM, Kd};
            const EpiResid E{ws, INP(0), xbuf, (isdown ? 1 : 0) | (sub << 1) | (l << 2)};
            pg8::StaticOrder S; S.init(T, DM, G, cx.bid);
            pg8::gemm_phase<EpiResid, pg8::StaticOrder, false, PG8_SP2>(lds, g, S, E, cx.tid);
        } else if (type == PH_IN || type == PH_GEMM_MLA) {
            const int nsub = (type == PH_GEMM_MLA) ? 2 : 1;
            for (int si = 0; si < nsub; ++si) {
                pg8::Gemm g; EpiStore E;
                if (type == PH_IN && l == 0) {
                    g = pg8::Gemm{(const pg8::bf16_t*)(ws + WS_A), (const pg8::bf16_t*)(ws + WS_WIN_E), T, 3840, DM};
                    E = EpiStore{(bf16*)(ws + WS_QK), (bf16*)(ws + WS_VA), (bf16*)(ws + WS_LAT), (bf16*)(ws + WS_LAT), 2048, 1024, 768, 768, 8, 12, 1000, -1, nullptr, (const float*)(ws + WS_SSQ), (const float*)(ws + WS_BIASV) + BV_IN_E, 3840, 0};
                } else if (type == PH_IN) {
                    g = pg8::Gemm{(const pg8::bf16_t*)(ws + WS_A), (const pg8::bf16_t*)(ws + WS_WIN_O), T, 4352, DM};
                    E = EpiStore{(bf16*)(ws + WS_QK), (bf16*)(ws + WS_KH), (bf16*)(ws + WS_VA), (bf16*)(ws + WS_OG), 1024, 1024, 1024, 1024, 4, 8, 12, 16, (float*)(ws + WS_FLOG), (const float*)(ws + WS_SSQ), (const float*)(ws + WS_BIASV) + BV_IN_O, 4352, (64 << 8) | (64 << 16)};
                } else if (si == 0) {
                    g = pg8::Gemm{(const pg8::bf16_t*)(ws + WS_CQN), (const pg8::bf16_t*)(ws + WS_WQB), T, 768, 384};
                    E = EpiStore{(bf16*)(ws + WS_QB), (bf16*)(ws + WS_QB), (bf16*)(ws + WS_QB), (bf16*)(ws + WS_QB), 768, 768, 768, 768, 1000, 1000, 1000, -1, nullptr, nullptr, (const float*)(ws + WS_BIASV), 0, 0};
                } else {
                    g = pg8::Gemm{(const pg8::bf16_t*)(ws + WS_CKVN), (const pg8::bf16_t*)(ws + WS_WKVB), T, 1536, 256};
                    E = EpiStore{(bf16*)(ws + WS_KVB), (bf16*)(ws + WS_KVB), (bf16*)(ws + WS_KVB), (bf16*)(ws + WS_KVB), 1536, 1536, 1536, 1536, 1000, 1000, 1000, -1, nullptr, nullptr, (const float*)(ws + WS_BIASV), 0, 0};
                }
                pg8::StaticOrder S; S.init(T, g.N, G, cx.bid);
                pg8::gemm_phase<EpiStore, pg8::StaticOrder, PG8_ALIGN, PG8_SP2>(lds, g, S, E, cx.tid);
                __syncthreads();
            }
        } else if (type == PH_PREP1E) prep1e_phase(a, cx);
        else if (type == PH_PREP2E) prep2e_phase(a, cx);
        else if (type == PH_PREPO) prepo_phase(a, cx, lds);
        else if (type == PH_ATT_DIFF) attn_diff_phase(a, cx, lds);
        else if (type == PH_ATT_MLA) attn_mla_phase(a, cx, lds);
        else if (type == PH_ATT_FOX) attn_fox_phase(a, cx, lds);
        if (ph + 1 < a.ph_hi) xcd_barrier(bar);
    }
}

extern "C" void kernel_launch(void* const* d_in, const int* in_sizes, int n_in, void* d_out, int out_size, void* d_ws, size_t ws_size, hipStream_t stream) {
    static int grid = 0;
    if (grid == 0) {
        if (n_in != 31 || out_size != T * DM || ws_size < WS_END) { fprintf(stderr, "kernel_launch: unexpected problem: n_in %d out %d ws %zu (need %zu)\n", n_in, out_size, ws_size, (size_t)WS_END); grid = -1; return; }
        int dev = 0, cus = 0, per_cu = 0;
        (void)hipGetDevice(&dev);
        (void)hipDeviceGetAttribute(&cus, hipDeviceAttributeMultiprocessorCount, dev);
        if (hipFuncSetAttribute((const void*)mk_fwd, hipFuncAttributeMaxDynamicSharedMemorySize, LDS_BYTES) != hipSuccess) fprintf(stderr, "kernel_launch: hipFuncSetAttribute failed\n");
        if (hipOccupancyMaxActiveBlocksPerMultiprocessor(&per_cu, (const void*)mk_fwd, NTHR, LDS_BYTES) != hipSuccess || per_cu < 1) { fprintf(stderr, "kernel_launch: occupancy query says %d\n", per_cu); per_cu = 1; }
        (void)hipGetLastError();
        if (cus <= 0) cus = 256;
        grid = cus * (per_cu > 1 ? 1 : per_cu);
    }
    if (grid < 0) return;
    Args a{};
    for (int i = 0; i < 31; ++i) a.in[i] = (const float*)d_in[i];
    a.out = (float*)d_out; a.ws = (unsigned char*)d_ws;
    if (hipMemsetAsync((char*)d_ws + WS_CTL, 0, CTL_ZERO_BYTES, stream) != hipSuccess) { fprintf(stderr, "kernel_launch: hipMemsetAsync failed\n"); return; }
    a.ph_lo = 0; a.ph_hi = NPHASES;
    void* args[] = {&a};
    hipError_t e = hipLaunchCooperativeKernel((const void*)mk_fwd, dim3(grid), dim3(NTHR), args, LDS_BYTES, stream);
    if (e != hipSuccess) fprintf(stderr, "kernel_launch: cooperative launch failed: %s (grid %d)\n", hipGetErrorString(e), grid);
}
```
